# Optimizing an MI355X kernel written in HIP

```python
import math
import jax, jax.numpy as jnp
from jax import lax
import numpy as np

D_MODEL = 1024
BATCH = 32
SEQ = 2048
DEPTH = 4
DEC_BATCH = 2
DEC_SEQ = 8192
PAST_LEN = 128

HEAD_DIM = 64
EPS = 1e-6
NEG = -1e30
A_HEADS = 16
A_KV_HEADS = 4
A_RADIUS = 128
B_PAIRS = ((128, 1), (512, 4), (2048, 16))
B_HEADS = 8
C_HEADS = 8
C_QK_DIM = 64
C_V_DIM = 2 * C_QK_DIM
C_QBLOCK = 128
D_HEADS = 4
D_K_DIM = 128
D_V_DIM = 128
D_GATE_RANK = 16
D_GATE_TAU = 16.0
D_CHUNK = 64

N_EVEN = (DEPTH + 1) // 2
N_ODD = DEPTH // 2
A_WIDTH = A_HEADS * HEAD_DIM
A_KV_WIDTH = A_KV_HEADS * HEAD_DIM
B_WIDTH = B_HEADS * HEAD_DIM
B_QKV_WIDTH = len(B_PAIRS) * B_WIDTH
EVEN_SPLITS = (A_WIDTH, A_KV_WIDTH, A_KV_WIDTH, A_WIDTH, B_QKV_WIDTH, B_QKV_WIDTH, B_QKV_WIDTH, B_WIDTH)
EVEN_COLS = sum(EVEN_SPLITS)
EVEN_WIDTH = A_WIDTH + B_WIDTH
C_QK_WIDTH = C_HEADS * 2 * C_QK_DIM
C_WIDTH = C_HEADS * C_V_DIM
D_KEY_WIDTH = D_HEADS * D_K_DIM
D_WIDTH = D_HEADS * D_V_DIM
ODD_SPLITS = (C_QK_WIDTH, C_QK_WIDTH, C_WIDTH, C_WIDTH, D_KEY_WIDTH, D_KEY_WIDTH, D_WIDTH, D_WIDTH, 2 * D_GATE_RANK)
ODD_COLS = sum(ODD_SPLITS)
ODD_WIDTH = C_WIDTH + D_WIDTH

kernel_name = "hybrid_bidir_encoder_trunk"


def rmsnorm(x, g):
    x32 = x.astype(jnp.float32)
    y = x32 * lax.rsqrt(jnp.mean(x32 * x32, axis=-1, keepdims=True) + EPS) * g.astype(jnp.float32)
    return y.astype(x.dtype)


def split_cols(z, sizes):
    idx = np.cumsum(np.array(sizes))[:-1].tolist()
    return jnp.split(z, idx, axis=-1)


def alibi_slopes(n):
    return jnp.asarray([2.0 ** (-8.0 * (i + 1) / n) for i in range(n)], dtype=jnp.float32)


def banded_attention(q, k, v, slopes, radius, stride, sink=None):
    Bsz, Hq, T, hd = q.shape
    Hkv = k.shape[1]
    G = Hq // Hkv
    blk = radius
    n = -(-T // blk)
    Tp = n * blk
    pad = Tp - T
    qb = jnp.pad(q, ((0, 0), (0, 0), (0, pad), (0, 0))).reshape(Bsz, Hkv, G, n, blk, hd)

    def windows(a):
        ap = jnp.pad(a, ((0, 0), (0, 0), (blk, blk + pad), (0, 0))).reshape(Bsz, Hkv, n + 2, blk, hd)
        return jnp.concatenate([ap[:, :, :-2], ap[:, :, 1:-1], ap[:, :, 2:]], axis=-2)

    kw, vw = windows(k), windows(v)
    s = jnp.einsum('bkgnqd,bknsd->bkgnqs', qb, kw, preferred_element_type=jnp.float32) * (hd ** -0.5)
    qpos = jnp.arange(Tp).reshape(n, blk)[:, :, None]
    kpos = (jnp.arange(n)[:, None] * blk - blk + jnp.arange(3 * blk)[None, :])[:, None, :]
    dist = jnp.abs(qpos - kpos)
    valid = (dist <= radius) & (kpos >= 0) & (kpos < T)
    s = s - slopes.reshape(Hkv, G)[None, :, :, None, None, None] * (stride * dist).astype(jnp.float32)
    s = jnp.where(valid, s, NEG)
    m = jnp.max(s, axis=-1)
    if sink is not None:
        sk = sink.astype(jnp.float32).reshape(Hkv, G)[None, :, :, None, None]
        m = jnp.maximum(m, sk)
    p = jnp.exp(s - m[..., None])
    denom = jnp.sum(p, axis=-1)
    if sink is not None:
        denom = denom + jnp.exp(sk - m)
    o = jnp.einsum('bkgnqs,bknsd->bkgnqd', p.astype(v.dtype), vw, preferred_element_type=jnp.float32) / denom[..., None]
    lse = m + jnp.log(denom)
    o = o.reshape(Bsz, Hq, Tp, hd)[:, :, :T]
    lse = lse.reshape(Bsz, Hq, Tp)[:, :, :T]
    return o, lse


def dilated_mixture(q, k, v, slopes):
    P, Bsz, H, T, hd = q.shape
    outs, lses = [], []
    for p, (window, dil) in enumerate(B_PAIRS):
        radius = window // (2 * dil)
        L = T // dil

        def gather(a):
            return a.reshape(Bsz, H, L, dil, hd).transpose(0, 3, 1, 2, 4).reshape(Bsz * dil, H, L, hd)

        o, lse = banded_attention(gather(q[p]), gather(k[p]), gather(v[p]), slopes, radius, dil)
        outs.append(o.reshape(Bsz, dil, H, L, hd).transpose(0, 2, 3, 1, 4).reshape(Bsz, H, T, hd))
        lses.append(lse.reshape(Bsz, dil, H, L).transpose(0, 2, 3, 1).reshape(Bsz, H, T))
    wts = jax.nn.softmax(jnp.stack(lses, axis=0), axis=0)
    return jnp.einsum('pbht,pbhtd->bhtd', wts, jnp.stack(outs, axis=0))


def diff_attention(q, k, v, slopes, lam):
    Bsz, H, _, T, dk = q.shape
    nq = T // C_QBLOCK
    qb = jnp.moveaxis(q.reshape(Bsz, H, 2, nq, C_QBLOCK, dk), 3, 0)
    starts = jnp.arange(nq) * C_QBLOCK
    kpos = jnp.arange(T)

    def block(args):
        qi, start = args
        s = jnp.einsum('bhiqd,bhisd->bhiqs', qi, k, preferred_element_type=jnp.float32) * (dk ** -0.5)
        qpos = start + jnp.arange(C_QBLOCK)
        dist = jnp.abs(qpos[:, None] - kpos[None, :]).astype(jnp.float32)
        s = s - slopes[None, :, None, None, None] * dist[None, None, None]
        p = jax.nn.softmax(s, axis=-1)
        a = p[:, :, 0] - lam * p[:, :, 1]
        return jnp.einsum('bhqs,bhsd->bhqd', a.astype(v.dtype), v, preferred_element_type=jnp.float32)

    o = lax.map(block, (qb, starts))
    return jnp.moveaxis(o, 0, 2).reshape(Bsz, H, T, v.shape[-1])


def gla_direction(q, k, v, log_a, strict):
    Bsz, H, T, dk = q.shape
    dv = v.shape[-1]
    C = D_CHUNK
    n = T // C
    q = q.reshape(Bsz, H, n, C, dk)
    k = k.reshape(Bsz, H, n, C, dk)
    v = v.reshape(Bsz, H, n, C, dv)
    b = jnp.cumsum(log_a.reshape(Bsz, H, n, C, dk), axis=3)
    b_last = b[:, :, :, -1:, :]
    q_e = q * jnp.exp(b)
    k_e = k * jnp.exp(-b)
    k_s = k * jnp.exp(b_last - b)
    mask = jnp.tril(jnp.ones((C, C), jnp.float32), k=-1 if strict else 0)
    a = jnp.einsum('bhncd,bhnsd->bhncs', q_e, k_e) * mask
    intra = jnp.einsum('bhncs,bhnsv->bhncv', a, v)
    kv = jnp.einsum('bhncd,bhncv->bhndv', k_s, v)
    decay = jnp.exp(b_last[:, :, :, 0, :])

    def step(S, inp):
        dec, kv_c = inp
        return dec[..., None] * S + kv_c, S

    S0 = jnp.zeros((Bsz, H, dk, dv), jnp.float32)
    _, S_prev = lax.scan(step, S0, (jnp.moveaxis(decay, 2, 0), jnp.moveaxis(kv, 2, 0)))
    S_prev = jnp.moveaxis(S_prev, 0, 2)
    inter = jnp.einsum('bhncd,bhndv->bhncv', q_e, S_prev)
    return (intra + inter).reshape(Bsz, H, T, dv)


def even_layer(x, g, w_in, w_out, sink):
    Bsz, T, _ = x.shape
    h = rmsnorm(x, g)
    z = jnp.einsum('btd,dc->btc', h, w_in)
    qa, ka, va, ga, qb, kb, vb, gb = split_cols(z, EVEN_SPLITS)

    def heads(a, nh):
        return a.reshape(Bsz, T, nh, HEAD_DIM).transpose(0, 2, 1, 3)

    oa, _ = banded_attention(heads(qa, A_HEADS), heads(ka, A_KV_HEADS), heads(va, A_KV_HEADS),
                             alibi_slopes(A_HEADS), A_RADIUS, 1, sink)
    oa = oa.transpose(0, 2, 1, 3).reshape(Bsz, T, A_WIDTH)

    def groups(a):
        return a.reshape(Bsz, T, len(B_PAIRS), B_HEADS, HEAD_DIM).transpose(2, 0, 3, 1, 4)

    ob = dilated_mixture(groups(qb), groups(kb), groups(vb), alibi_slopes(B_HEADS))
    ob = ob.transpose(0, 2, 1, 3).reshape(Bsz, T, B_WIDTH)
    y = jnp.concatenate([oa * jax.nn.silu(ga.astype(jnp.float32)), ob * jax.nn.silu(gb.astype(jnp.float32))], axis=-1)
    return x + jnp.einsum('btc,cd->btd', y.astype(x.dtype), w_out).astype(x.dtype)


def odd_layer(x, g, w_in, w_out, lam_p, subln_g, w_gate2, b_gate, gla_g, layer_idx):
    Bsz, T, _ = x.shape
    h = rmsnorm(x, g)
    z = jnp.einsum('btd,dc->btc', h, w_in)
    qc, kc, vc, gc, qd, kd, vd, gd, ad = split_cols(z, ODD_SPLITS)

    def qk_pair(a):
        return a.reshape(Bsz, T, C_HEADS, 2, C_QK_DIM).transpose(0, 2, 3, 1, 4)

    vch = vc.reshape(Bsz, T, C_HEADS, C_V_DIM).transpose(0, 2, 1, 3)
    lam_init = 0.8 - 0.6 * math.exp(-0.3 * layer_idx)
    lp = lam_p.astype(jnp.float32)
    lam = jnp.exp(jnp.sum(lp[0] * lp[1])) - jnp.exp(jnp.sum(lp[2] * lp[3])) + lam_init
    oc = diff_attention(qk_pair(qc), qk_pair(kc), vch, alibi_slopes(C_HEADS), lam)
    oc = rmsnorm(oc, subln_g) * (1.0 - lam_init)
    oc = oc.transpose(0, 2, 1, 3).reshape(Bsz, T, C_WIDTH)

    rank = ad.astype(jnp.float32).reshape(Bsz, T, 2, D_GATE_RANK)
    log_a = jax.nn.log_sigmoid(jnp.einsum('btpr,prk->pbtk', rank, w_gate2.astype(jnp.float32))
                               + b_gate.astype(jnp.float32)[:, None, None, :]) / D_GATE_TAU

    def dheads(a, dh):
        return a.astype(jnp.float32).reshape(Bsz, T, D_HEADS, dh).transpose(0, 2, 1, 3)

    qh = dheads(qd, D_K_DIM) * (D_K_DIM ** -0.5)
    kh = dheads(kd, D_K_DIM)
    vh = dheads(vd, D_V_DIM)
    la_f = dheads(log_a[0], D_K_DIM)
    la_b = dheads(log_a[1], D_K_DIM)
    fl = lambda a: jnp.flip(a, axis=2)
    o_f = gla_direction(qh, kh, vh, la_f, strict=False)
    o_b = fl(gla_direction(fl(qh), fl(kh), fl(vh), fl(la_b), strict=True))
    od = rmsnorm(o_f + o_b, gla_g).transpose(0, 2, 1, 3).reshape(Bsz, T, D_WIDTH)

    y = jnp.concatenate([oc * jax.nn.silu(gc.astype(jnp.float32)), od * jax.nn.silu(gd.astype(jnp.float32))], axis=-1)
    return x + jnp.einsum('btc,cd->btd', y.astype(x.dtype), w_out).astype(x.dtype)


def trunk(x, norm_g, final_norm_g, even_w_in, even_w_out, sink_logit, odd_w_in, odd_w_out,
          diff_lambda, diff_subln_g, gla_w_gate2, gla_b_gate, gla_norm_g):
    for i in range(DEPTH):
        j = i // 2
        if i % 2 == 0:
            x = even_layer(x, norm_g[i], even_w_in[j], even_w_out[j], sink_logit[j])
        else:
            x = odd_layer(x, norm_g[i], odd_w_in[j], odd_w_out[j], diff_lambda[j], diff_subln_g[j],
                          gla_w_gate2[j], gla_b_gate[j], gla_norm_g[j], i)
    return rmsnorm(x, final_norm_g)


def setup_inputs(seed: int = 0) -> dict:
    key = jax.random.key(seed)
    ks = jax.random.split(key, 14)
    nrm = lambda k, s: jax.random.normal(k, s, jnp.float32)
    return {
        "x_prompt": nrm(ks[0], (BATCH, SEQ, D_MODEL)),
        "x_sample": nrm(ks[1], (DEC_BATCH, DEC_SEQ, D_MODEL)),
        "norm_g": 1.0 + 0.01 * nrm(ks[2], (DEPTH, D_MODEL)),
        "final_norm_g": 1.0 + 0.01 * nrm(ks[3], (D_MODEL,)),
        "even_w_in": nrm(ks[4], (N_EVEN, D_MODEL, EVEN_COLS)) * D_MODEL ** -0.5,
        "even_w_out": nrm(ks[5], (N_EVEN, EVEN_WIDTH, D_MODEL)) * EVEN_WIDTH ** -0.5,
        "sink_logit": nrm(ks[6], (N_EVEN, A_HEADS)),
        "odd_w_in": nrm(ks[7], (N_ODD, D_MODEL, ODD_COLS)) * D_MODEL ** -0.5,
        "odd_w_out": nrm(ks[8], (N_ODD, ODD_WIDTH, D_MODEL)) * ODD_WIDTH ** -0.5,
        "diff_lambda": 0.1 * nrm(ks[9], (N_ODD, 4, C_QK_DIM)),
        "diff_subln_g": 1.0 + 0.01 * nrm(ks[10], (N_ODD, C_V_DIM)),
        "gla_w_gate2": nrm(ks[11], (N_ODD, 2, D_GATE_RANK, D_KEY_WIDTH)) * D_GATE_RANK ** -0.5,
        "gla_b_gate": 0.1 * nrm(ks[12], (N_ODD, 2, D_KEY_WIDTH)),
        "gla_norm_g": 1.0 + 0.01 * nrm(ks[13], (N_ODD, D_V_DIM)),
    }


def reference(x_prompt, x_sample, norm_g, final_norm_g, even_w_in, even_w_out, sink_logit,
              odd_w_in, odd_w_out, diff_lambda, diff_subln_g, gla_w_gate2, gla_b_gate, gla_norm_g):
    y_prompt = trunk(x_prompt, norm_g, final_norm_g, even_w_in, even_w_out, sink_logit, odd_w_in, odd_w_out,
                     diff_lambda, diff_subln_g, gla_w_gate2, gla_b_gate, gla_norm_g)
    y_sample = trunk(x_sample, norm_g, final_norm_g, even_w_in, even_w_out, sink_logit, odd_w_in, odd_w_out,
                     diff_lambda, diff_subln_g, gla_w_gate2, gla_b_gate, gla_norm_g)
    return (y_prompt, y_sample)
```

```cpp
#include <hip/hip_runtime.h>
#include <hip/hip_cooperative_groups.h>
#include <cstdio>
namespace cg = cooperative_groups;

#define DI __device__ __forceinline__
typedef unsigned short u16;
typedef __attribute__((ext_vector_type(8))) short bf16x8;
typedef __attribute__((ext_vector_type(4))) short bf16x4;
typedef __attribute__((ext_vector_type(16))) float f32x16;
typedef __attribute__((ext_vector_type(2))) __bf16 bf2_t;
typedef __attribute__((ext_vector_type(2))) float f2_t;
typedef __attribute__((ext_vector_type(4))) unsigned u32x4;
typedef __attribute__((ext_vector_type(2))) unsigned u32x2;
typedef __attribute__((ext_vector_type(4))) float f32x4;
#define MFMA(a, b, c) __builtin_amdgcn_mfma_f32_32x32x16_bf16((a), (b), (c), 0, 0, 0)

constexpr int NTHR = 256;
constexpr int DM = 1024;
constexpr int TOK = 16384;
constexpr int NGROUP = 5;
constexpr int ECOLS = 7680;
constexpr int OCOLS = 6176;
constexpr int OCOLS_PAD = 6272;
constexpr int YW = 1536;
constexpr int SMEM_BYTES = 77824;
constexpr float LOG2E = 1.4426950408889634f;
constexpr float NEG_INF = -__builtin_inff();

struct Params {
  const float* x_prompt; const float* x_sample; const float* norm_g; const float* final_g;
  const float* even_w_in; const float* even_w_out; const float* sink; const float* odd_w_in; const float* odd_w_out;
  const float* diff_lambda; const float* subln_g; const float* gate2; const float* bgate; const float* gla_g;
  float* out;
  u16* wte_in; u16* wto_in; u16* wte_out; u16* wto_out;
  u16* hb; u16* z; u16* y;
  float* lse; float* of; float* ob; float* oif; float* oib; u16* vtb; u16* opart; float* mlpart; u16* qebuf; float* kvbuf; float* decbuf; int* ctr; unsigned* bar;
};

DI unsigned pk2(float a, float b) { f2_t v = {a, b}; bf2_t r = __builtin_convertvector(v, bf2_t); return __builtin_bit_cast(unsigned, r); }
DI u16 f2bf(float a) { return (u16)(pk2(a, 0.f) & 0xffffu); }
DI float bf2f(u16 v) { return __uint_as_float(((unsigned)v) << 16); }
DI float bflo(unsigned v) { return __uint_as_float(v << 16); }
DI float bfhi(unsigned v) { return __uint_as_float(v & 0xffff0000u); }
DI float fexp2(float x) { return __builtin_amdgcn_exp2f(x); }
DI float flog2(float x) { return __builtin_amdgcn_logf(x); }
DI float frcp(float x) { return __builtin_amdgcn_rcpf(x); }
DI float silu(float x) { return x * frcp(1.f + fexp2(-x * LOG2E)); }
DI float shx(float v, int m, int lane) { return __int_as_float(__builtin_amdgcn_ds_bpermute((lane ^ m) << 2, __float_as_int(v))); }
DI float wave_sum(float v, int lane) { for (int o = 32; o; o >>= 1) v += shx(v, o, lane); return v; }
DI bf16x8 cat8(bf16x4 lo, bf16x4 hi) { return __builtin_shufflevector(lo, hi, 0, 1, 2, 3, 4, 5, 6, 7); }
DI f32x16 zero16() { f32x16 z; for (int i = 0; i < 16; ++i) z[i] = 0.f; return z; }

DI float uni(float x) { return __int_as_float(__builtin_amdgcn_readfirstlane(__float_as_int(x))); }
DI int opaque_tid() { int t = threadIdx.x; asm volatile("" : "+v"(t)); return t; }

DI int next_item(int* ctr, char* smem) {
  int* sh = (int*)(smem + SMEM_BYTES - 16);
  __syncthreads();
  if (threadIdx.x == 0) *sh = atomicAdd(ctr, 1);
  __syncthreads();
  return *sh;
}

DI void prep_transpose(const float* __restrict__ src, const float* __restrict__ g, int R, int C, int Cpad, u16* __restrict__ dst, char* smem) {
  float* tl = (float*)smem;
  const int tcols = Cpad / 64, ntiles = (R / 64) * tcols;
  const int tid = opaque_tid(), cc = tid & 63, rr = tid >> 6;
  for (int tile = blockIdx.x; tile < ntiles; tile += gridDim.x) {
    const int r0 = (tile / tcols) * 64, c0 = (tile % tcols) * 64;
#pragma unroll
    for (int i = 0; i < 16; ++i) {
      const int row = i * 4 + rr, c = c0 + cc;
      float v = 0.f;
      if (c < C) { v = src[(size_t)(r0 + row) * C + c]; if (g) v *= g[r0 + row]; }
      tl[row * 65 + cc] = v;
    }
    __syncthreads();
#pragma unroll
    for (int i = 0; i < 16; ++i) {
      const int crow = i * 4 + rr;
      dst[(size_t)(c0 + crow) * R + r0 + cc] = f2bf(tl[cc * 65 + crow]);
    }
    __syncthreads();
  }
}

DI void norm_rows(const float* __restrict__ xin, u16* __restrict__ hb) {
  const int tid = opaque_tid(); const int lane = tid & 63, gw = blockIdx.x * 4 + (tid >> 6), nw = gridDim.x * 4;
  for (int row = gw; row < TOK; row += nw) {
    const f32x4* p = (const f32x4*)(xin + (size_t)row * DM);
    f32x4 v[4]; float ss = 0.f;
#pragma unroll
    for (int i = 0; i < 4; ++i) { v[i] = p[lane + 64 * i]; ss += v[i].x * v[i].x + v[i].y * v[i].y + v[i].z * v[i].z + v[i].w * v[i].w; }
    ss = wave_sum(ss, lane);
    const float rs = rsqrtf(ss * (1.f / DM) + 1e-6f);
#pragma unroll
    for (int i = 0; i < 4; ++i) {
      u32x2 o; o.x = pk2(v[i].x * rs, v[i].y * rs); o.y = pk2(v[i].z * rs, v[i].w * rs);
      *(u32x2*)(hb + (size_t)row * DM + (lane + 64 * i) * 4) = o;
    }
  }
}
DI void final_norm_rows(float* __restrict__ x, const float* __restrict__ g) {
  const int tid = opaque_tid(); const int lane = tid & 63, gw = blockIdx.x * 4 + (tid >> 6), nw = gridDim.x * 4;
  for (int row = gw; row < TOK; row += nw) {
    f32x4* p = (f32x4*)(x + (size_t)row * DM);
    const f32x4* gp = (const f32x4*)g;
    f32x4 v[4]; float ss = 0.f;
#pragma unroll
    for (int i = 0; i < 4; ++i) { v[i] = p[lane + 64 * i]; ss += v[i].x * v[i].x + v[i].y * v[i].y + v[i].z * v[i].z + v[i].w * v[i].w; }
    ss = wave_sum(ss, lane);
    const float rs = rsqrtf(ss * (1.f / DM) + 1e-6f);
#pragma unroll
    for (int i = 0; i < 4; ++i) {
      const f32x4 gg = gp[lane + 64 * i];
      f32x4 o; o.x = v[i].x * rs * gg.x; o.y = v[i].y * rs * gg.y; o.z = v[i].z * rs * gg.z; o.w = v[i].w * rs * gg.w;
      p[lane + 64 * i] = o;
    }
  }
}

template <int EPI>
DI void gemm_phase(const u16* __restrict__ A, int lda, const u16* __restrict__ Bt, int K, int ntn,
                   u16* __restrict__ zout, int ldz, const float* __restrict__ resid, float* __restrict__ xout, u16* __restrict__ vtout, int T, char* smem) {
  constexpr int LS = 72;
  u16* As = (u16*)smem;
  u16* Bs = As + 2 * 128 * LS;
  const int tid = opaque_tid(), lane = tid & 63, wave = tid >> 6;
  const int wm = wave >> 1, wn = wave & 1, r = lane & 31, h = lane >> 5;
  const int ntiles = (TOK / 128) * ntn, KT = K / 64;
  const int RN = (ntn % 6 == 0) ? 6 : ((ntn % 7 == 0) ? 7 : 8);
  const int rpr = ntn / RN, per = ntiles >> 3, nb8 = gridDim.x >> 3;
  for (int li = (int)(blockIdx.x >> 3); li < per; li += nb8) {
    const int ti = (int)(blockIdx.x & 7) * per + li;
    const int rect = ti / (8 * RN), within = ti - rect * (8 * RN);
    const int band = rect / rpr, rcol = rect - band * rpr;
    const int m0 = (band * 8 + (within & 7)) * 128, n0 = (rcol * RN + (within >> 3)) * 128;
    f32x16 acc[2][2];
#pragma unroll
    for (int i = 0; i < 2; ++i) for (int j = 0; j < 2; ++j) acc[i][j] = zero16();
    const int srow = lane >> 3, spos = lane & 7;
    const int ch_ = spos ^ ((4 * wave + (srow >> 1)) & 7);
    const u16* __restrict__ ag = A + (size_t)(m0 + 8 * wave + srow) * lda + ch_ * 8;
    const u16* __restrict__ bg = Bt + (size_t)(n0 + 8 * wave + srow) * K + ch_ * 8;
#define STAGE(BUF_, KT_) { _Pragma("unroll") for (int i = 0; i < 4; ++i) { \
      __builtin_amdgcn_global_load_lds((const unsigned*)(ag + (size_t)(32 * i) * lda + (KT_) * 64), (unsigned*)(smem + (BUF_) * 16384 + (4 * i + wave) * 1024), 16, 0, 0); \
      __builtin_amdgcn_global_load_lds((const unsigned*)(bg + (size_t)(32 * i) * K + (KT_) * 64), (unsigned*)(smem + 32768 + (BUF_) * 16384 + (4 * i + wave) * 1024), 16, 0, 0); } }
    __syncthreads();
    STAGE(0, 0);
    __syncthreads();
    const int ra_ = wm * 64 + r, rb_ = wn * 64 + r;
    const int fa_ = (ra_ >> 1) & 7, fb_ = (rb_ >> 1) & 7;
#pragma unroll 1
    for (int kt = 0; kt < KT; ++kt) {
      const int buf = kt & 1;
      if (kt + 1 < KT) STAGE(buf ^ 1, kt + 1);
      const char* ab = smem + buf * 16384 + ra_ * 128;
      const char* bb = smem + 32768 + buf * 16384 + rb_ * 128;
#pragma unroll
      for (int ks = 0; ks < 4; ++ks) {
        const int pa_ = ((2 * ks + h) ^ fa_) << 4, pb_ = ((2 * ks + h) ^ fb_) << 4;
        const bf16x8 a0 = *(const bf16x8*)(ab + pa_), a1 = *(const bf16x8*)(ab + 4096 + pa_);
        const bf16x8 b0 = *(const bf16x8*)(bb + pb_), b1 = *(const bf16x8*)(bb + 4096 + pb_);
        acc[0][0] = MFMA(a0, b0, acc[0][0]); acc[0][1] = MFMA(a0, b1, acc[0][1]);
        acc[1][0] = MFMA(a1, b0, acc[1][0]); acc[1][1] = MFMA(a1, b1, acc[1][1]);
      }
      __syncthreads();
    }
#undef STAGE
    if (EPI == 0 && vtout != nullptr && n0 >= 2048 && n0 < 3072) {
#pragma unroll
      for (int i = 0; i < 2; ++i)
#pragma unroll
        for (int j = 0; j < 2; ++j)
#pragma unroll
          for (int g4 = 0; g4 < 4; ++g4) {
            const int m = m0 + wm * 64 + i * 32 + 8 * g4 + 4 * h;
            const int n = n0 + wn * 64 + j * 32 + r;
            const int seq = m / T, t0_ = m - seq * T;
            const int g_ = (t0_ >> 2) & 3, t = (t0_ & ~15) | ((((g_ & 1) << 1) | (g_ >> 1)) << 2);
            u32x2 ov; ov.x = pk2(acc[i][j][4 * g4 + 0], acc[i][j][4 * g4 + 1]); ov.y = pk2(acc[i][j][4 * g4 + 2], acc[i][j][4 * g4 + 3]);
            *(u32x2*)(vtout + ((unsigned)(seq * 1024 + (n - 2048)) * (unsigned)T + (unsigned)t)) = ov;
          }
    } else
#pragma unroll
    for (int i = 0; i < 2; ++i)
#pragma unroll
      for (int j = 0; j < 2; ++j)
#pragma unroll
        for (int e = 0; e < 16; ++e) {
          const int m = m0 + wm * 64 + i * 32 + 8 * (e >> 2) + 4 * h + (e & 3);
          const int n = n0 + wn * 64 + j * 32 + r;
          if (EPI == 0) zout[(size_t)m * ldz + n] = f2bf(acc[i][j][e]);
          else xout[(size_t)m * DM + n] = resid[(size_t)m * DM + n] + acc[i][j][e];
        }
  }
}

DI void band_item(u16* __restrict__ z, size_t tok0, int dil, int res, int L, int i0, int R,
                  int qoff, int koff, int voff, float c2, float m_init, float l_init, int mode,
                  int goff, u16* __restrict__ y, int ycol, float* __restrict__ lse, int lidx, char* smem) {
  constexpr int ZS = ECOLS;
  u16* Ks = (u16*)smem;
  u16* Vs = Ks + 64 * 72;
  const int tid = opaque_tid(), lane = tid & 63, wave = tid >> 6, r = lane & 31, h = lane >> 5;
  const int q0 = i0 + 32 * wave, qi = q0 + r;
  const size_t qtok = tok0 + res + (size_t)qi * dil;
  bf16x8 qf[4];
#pragma unroll
  for (int ks = 0; ks < 4; ++ks) qf[ks] = *(const bf16x8*)(z + qtok * ZS + qoff + 16 * ks + 8 * h);
  f32x16 accO[2] = {zero16(), zero16()};
  float m = m_init, l = (h == 0) ? l_init : 0.f;
  const float scale2 = 0.125f * LOG2E;
  const int ntile = (128 + 2 * R) / 64;
  const int t_lo = (R - i0) > 0 ? (R - i0) / 64 : 0;
  int t_hi = (L - i0 + R) / 64; t_hi = (t_hi < ntile ? t_hi : ntile) - 1;
  const int lrow = tid >> 3, lch = tid & 7;
  u32x4 kr[2], vr[2];
  {
    const int kb = i0 - R + 64 * t_lo;
#pragma unroll
    for (int i = 0; i < 2; ++i) {
      const size_t ktok = tok0 + res + (size_t)(kb + lrow + 32 * i) * dil;
      kr[i] = *(const u32x4*)(z + ktok * ZS + koff + lch * 8);
      vr[i] = *(const u32x4*)(z + ktok * ZS + voff + lch * 8);
    }
  }
  for (int t = t_lo; t <= t_hi; ++t) {
    const int kb = i0 - R + 64 * t;
    __syncthreads();
#pragma unroll
    for (int i = 0; i < 2; ++i) {
      const int row = lrow + 32 * i;
      *(u32x4*)(Ks + row * 72 + lch * 8) = kr[i];
      *(u32x4*)(Vs + row * 96 + lch * 8) = vr[i];
    }
    __syncthreads();
    if (t < t_hi) {
#pragma unroll
      for (int i = 0; i < 2; ++i) {
        const size_t ktok = tok0 + res + (size_t)(kb + 64 + lrow + 32 * i) * dil;
        kr[i] = *(const u32x4*)(z + ktok * ZS + koff + lch * 8);
        vr[i] = *(const u32x4*)(z + ktok * ZS + voff + lch * 8);
      }
    }
    if (kb + 63 < q0 - R || kb > q0 + 31 + R) continue;
    f32x16 accS[2] = {zero16(), zero16()};
#pragma unroll
    for (int u = 0; u < 2; ++u)
#pragma unroll
      for (int ks = 0; ks < 4; ++ks) {
        const bf16x8 a = *(const bf16x8*)(Ks + (32 * u + r) * 72 + 16 * ks + 8 * h);
        accS[u] = MFMA(a, qf[ks], accS[u]);
      }
    float mx = NEG_INF;
    const float d0 = (float)(qi - kb - 4 * h), Rf = (float)R;
#pragma unroll
    for (int u = 0; u < 2; ++u)
#pragma unroll
      for (int e = 0; e < 16; ++e) {
        const float dd = fabsf(d0 - (float)(32 * u + 8 * (e >> 2) + (e & 3)));
        float sc = accS[u][e] * scale2 - c2 * dd;
        sc = (dd <= Rf) ? sc : NEG_INF;
        accS[u][e] = sc; mx = fmaxf(mx, sc);
      }
    mx = fmaxf(mx, shx(mx, 32, lane));
    const float mn = fmaxf(m, mx);
    const float alpha = fexp2(m - mn);
    m = mn;
    float ps = 0.f;
#pragma unroll
    for (int u = 0; u < 2; ++u)
#pragma unroll
      for (int e = 0; e < 16; ++e) { const float p = fexp2(accS[u][e] - mn); accS[u][e] = p; ps += p; }
    l = l * alpha + ps;
#pragma unroll
    for (int db = 0; db < 2; ++db)
#pragma unroll
      for (int e = 0; e < 16; ++e) accO[db][e] *= alpha;
    const int i16 = lane & 15;
    const unsigned lb = (unsigned)(size_t)Vs + (unsigned)((4 * h + (i16 >> 2)) * 192 + (16 * ((lane >> 4) & 1) + 4 * (i16 & 3)) * 2);
#pragma unroll
    for (int u = 0; u < 2; ++u) {
      bf16x4 vq[8];
      asm volatile(
        "ds_read_b64_tr_b16 %0, %8 offset:0\n\t"     "ds_read_b64_tr_b16 %1, %8 offset:1536\n\t"
        "ds_read_b64_tr_b16 %2, %8 offset:64\n\t"    "ds_read_b64_tr_b16 %3, %8 offset:1600\n\t"
        "ds_read_b64_tr_b16 %4, %8 offset:3072\n\t"  "ds_read_b64_tr_b16 %5, %8 offset:4608\n\t"
        "ds_read_b64_tr_b16 %6, %8 offset:3136\n\t"  "ds_read_b64_tr_b16 %7, %8 offset:4672\n\t"
        "s_waitcnt lgkmcnt(0)"
        : "=&v"(vq[0]), "=&v"(vq[1]), "=&v"(vq[2]), "=&v"(vq[3]), "=&v"(vq[4]), "=&v"(vq[5]), "=&v"(vq[6]), "=&v"(vq[7])
        : "v"(lb + (unsigned)(u * 6144)) : "memory");
#pragma unroll
      for (int s = 0; s < 2; ++s) {
        u32x4 pw;
        pw.x = pk2(accS[u][8 * s + 0], accS[u][8 * s + 1]); pw.y = pk2(accS[u][8 * s + 2], accS[u][8 * s + 3]);
        pw.z = pk2(accS[u][8 * s + 4], accS[u][8 * s + 5]); pw.w = pk2(accS[u][8 * s + 6], accS[u][8 * s + 7]);
        const bf16x8 pf = __builtin_bit_cast(bf16x8, pw);
#pragma unroll
        for (int db = 0; db < 2; ++db) {
          const int f = (s * 2 + db) * 2;
          const bf16x8 vf = cat8(vq[f], vq[f + 1]);
          accO[db] = MFMA(vf, pf, accO[db]);
        }
      }
    }
  }
  const float lt = l + shx(l, 32, lane);
  const float inv = 1.f / lt;
#pragma unroll
  for (int db = 0; db < 2; ++db)
#pragma unroll
    for (int g4 = 0; g4 < 4; ++g4) {
      const int d = 32 * db + 8 * g4 + 4 * h;
      float o0 = accO[db][4 * g4 + 0] * inv, o1 = accO[db][4 * g4 + 1] * inv, o2 = accO[db][4 * g4 + 2] * inv, o3 = accO[db][4 * g4 + 3] * inv;
      if (mode == 0) {
        const u32x2 gv = *(const u32x2*)(z + qtok * ZS + goff + d);
        o0 *= silu(bflo(gv.x)); o1 *= silu(bfhi(gv.x)); o2 *= silu(bflo(gv.y)); o3 *= silu(bfhi(gv.y));
        u32x2 ov; ov.x = pk2(o0, o1); ov.y = pk2(o2, o3);
        *(u32x2*)(y + qtok * YW + ycol + d) = ov;
      } else {
        u32x2 ov; ov.x = pk2(o0, o1); ov.y = pk2(o2, o3);
        *(u32x2*)(z + qtok * ZS + qoff + d) = ov;
      }
    }
  if (mode == 1 && h == 0) lse[qtok * 24 + lidx] = m + flog2(lt);
}

DI void diff_item(const u16* __restrict__ z, const u16* __restrict__ vt, unsigned tok0, int T, int hc, int i0, int st, int kv0, int kv1, float slope2,
                  u16* __restrict__ opart, float* __restrict__ mlpart, char* smem) {
  constexpr unsigned ZS = OCOLS_PAD;
  const int tid = opaque_tid(), lane = tid & 63, wave = tid >> 6, r = lane & 31, h = lane >> 5;
  const int qi = i0 + 32 * wave + r;
  const u16* __restrict__ zh = z + hc * 128;
  const unsigned qto = (tok0 + (unsigned)qi) * ZS;
  const float scale2 = 0.125f * LOG2E;
  unsigned c0pk = 0u, c1pk = 0u, bpk = 0u;
  if (h == 0) {
    const unsigned shi = pk2(slope2, 0.f) & 0xffffu;
    const unsigned slo = pk2(slope2 - __uint_as_float(shi << 16), 0.f) & 0xffffu;
    const unsigned c0 = pk2((float)r, 0.f) & 0xffffu, c1 = pk2((float)(32 + r), 0.f) & 0xffffu;
    c0pk = c0 | (c0 << 16); c1pk = c1 | (c1 << 16); bpk = shi | (slo << 16);
  }
  bf16x8 qf[4];
#pragma unroll
  for (int ks = 0; ks < 4; ++ks) {
    const u32x4 qv = *(const u32x4*)(zh + (qto + (unsigned)(st * 64 + 16 * ks + 8 * h)));
    u32x4 qs;
    qs.x = pk2(bflo(qv.x) * scale2, bfhi(qv.x) * scale2); qs.y = pk2(bflo(qv.y) * scale2, bfhi(qv.y) * scale2);
    qs.z = pk2(bflo(qv.z) * scale2, bfhi(qv.z) * scale2); qs.w = pk2(bflo(qv.w) * scale2, bfhi(qv.w) * scale2);
    qf[ks] = __builtin_bit_cast(bf16x8, qs);
  }
  f32x16 accO[4];
#pragma unroll
  for (int db = 0; db < 4; ++db) accO[db] = zero16();
  float m = 0.f, l = 0.f;
  constexpr int BUFB = 8192 + 16384;
  const int srow = lane >> 3, spos = lane & 7;
  const int ch_ = spos ^ ((4 * wave + (srow >> 1)) & 7);
  const unsigned sk = (tok0 + (unsigned)(8 * wave + srow)) * ZS + 1024u + (unsigned)(st * 64 + ch_ * 8);
  const unsigned sv = (tok0 * 8u + (unsigned)hc * (unsigned)T) * 128u + (unsigned)(8 * wave + srow) * (unsigned)T + (unsigned)(ch_ * 8);
#define DSTAGE(BUF_, KB_) { \
    _Pragma("unroll") for (int i = 0; i < 2; ++i) __builtin_amdgcn_global_load_lds((const unsigned*)(zh + (sk + (unsigned)((KB_) + 32 * i) * ZS)), (unsigned*)(smem + (BUF_) * BUFB + (wave + 4 * i) * 1024), 16, 0, 0); \
    _Pragma("unroll") for (int i = 0; i < 4; ++i) __builtin_amdgcn_global_load_lds((const unsigned*)(vt + (sv + (unsigned)(32 * i) * (unsigned)T + (unsigned)(KB_))), (unsigned*)(smem + (BUF_) * BUFB + 8192 + (wave + 4 * i) * 1024), 16, 0, 0); }
  __syncthreads();
  DSTAGE(0, kv0);
  __syncthreads();
  const int fk_ = (r >> 1) & 7;
  int buf = 0;
#pragma unroll 1
  for (int kb = kv0; kb < kv1; kb += 64, buf ^= 1) {
    if (kb + 64 < kv1) DSTAGE(buf ^ 1, kb + 64);
    const char* Kb = smem + buf * BUFB + r * 128;
    const char* Vb = smem + buf * BUFB + 8192 + r * 128;
    f32x16 accS[2] = {zero16(), zero16()};
    __builtin_amdgcn_s_setprio(1);
#pragma unroll
    for (int u = 0; u < 2; ++u)
#pragma unroll
      for (int ks = 0; ks < 4; ++ks) {
        const bf16x8 a = *(const bf16x8*)(Kb + u * 4096 + (((2 * ks + h) ^ fk_) << 4));
        accS[u] = MFMA(a, qf[ks], accS[u]);
      }
    const int q0w = i0 + 32 * wave;
    const bool left = (kb + 63 <= q0w), right = (kb >= q0w + 31);
    const float cl = left ? slope2 * (float)(qi - kb) : (right ? -slope2 * (float)(qi - kb) : 0.f);
    {
      const float nref = -(m + cl);
      const unsigned rhi = pk2(nref, 0.f) & 0xffffu;
      const unsigned rlo = pk2(nref - __uint_as_float(rhi << 16), 0.f) & 0xffffu;
      const unsigned rpk = (h == 0) ? (rhi | (rlo << 16)) : 0u, opk = (h == 0) ? 0x3f803f80u : 0u;
      const unsigned spk = left ? bpk : (right ? (bpk ^ 0x80008000u) : 0u);
      const u32x4 a0 = {c0pk, opk, 0u, 0u}, a1 = {c1pk, opk, 0u, 0u}, bb = {spk, rpk, 0u, 0u};
      accS[0] = MFMA(__builtin_bit_cast(bf16x8, a0), __builtin_bit_cast(bf16x8, bb), accS[0]);
      accS[1] = MFMA(__builtin_bit_cast(bf16x8, a1), __builtin_bit_cast(bf16x8, bb), accS[1]);
    }
    __builtin_amdgcn_s_setprio(0);
    if (!(left || right)) {
      const float d0 = (float)(qi - kb - 4 * h);
#pragma unroll
      for (int u = 0; u < 2; ++u)
#pragma unroll
        for (int e = 0; e < 16; ++e) {
          const float dd = fabsf(d0 - (float)(32 * u + 8 * (e >> 2) + (e & 3)));
          accS[u][e] -= slope2 * dd;
        }
    }
    float ps = 0.f;
#pragma unroll
    for (int u = 0; u < 2; ++u)
#pragma unroll
      for (int e = 0; e < 16; ++e) { const float p = fexp2(accS[u][e]); accS[u][e] = p; ps += p; }
    if (__builtin_amdgcn_ballot_w64(ps > 65536.f) != 0ull) {
      float pm = 0.f;
#pragma unroll
      for (int u = 0; u < 2; ++u)
#pragma unroll
        for (int e = 0; e < 16; ++e) pm = fmaxf(pm, accS[u][e]);
      pm = fmaxf(pm, shx(pm, 32, lane));
      const float delta = pm > 1.f ? floorf(flog2(pm)) : 0.f;
      const float sc = fexp2(-delta);
      ps *= sc; l *= sc; m += delta;
#pragma unroll
      for (int db = 0; db < 4; ++db)
#pragma unroll
        for (int e = 0; e < 16; ++e) accO[db][e] *= sc;
#pragma unroll
      for (int u = 0; u < 2; ++u)
#pragma unroll
        for (int e = 0; e < 16; ++e) accS[u][e] *= sc;
    }
    l += ps;
    __builtin_amdgcn_s_setprio(1);
#pragma unroll
    for (int u = 0; u < 2; ++u)
#pragma unroll
      for (int s2 = 0; s2 < 2; ++s2) {
        u32x4 pw;
        pw.x = pk2(accS[u][8 * s2 + 0], accS[u][8 * s2 + 1]); pw.y = pk2(accS[u][8 * s2 + 2], accS[u][8 * s2 + 3]);
        pw.z = pk2(accS[u][8 * s2 + 4], accS[u][8 * s2 + 5]); pw.w = pk2(accS[u][8 * s2 + 6], accS[u][8 * s2 + 7]);
        const bf16x8 pf = __builtin_bit_cast(bf16x8, pw);
#pragma unroll
        for (int db = 0; db < 4; ++db) {
          const bf16x8 vf = *(const bf16x8*)(Vb + db * 4096 + (((4 * u + 2 * s2 + h) ^ fk_) << 4));
          accO[db] = MFMA(vf, pf, accO[db]);
        }
      }
    __builtin_amdgcn_s_setprio(0);
    __syncthreads();
  }
#undef DSTAGE
  const float lt = l + shx(l, 32, lane);
  if (h == 0) { float2 mlv; mlv.x = m; mlv.y = lt; *(float2*)(mlpart + ((size_t)(tok0 + (unsigned)qi) * 8 + hc) * 2) = mlv; }
  __syncthreads();
  u16* Ot = (u16*)smem;
#pragma unroll
  for (int db = 0; db < 4; ++db)
#pragma unroll
    for (int g4 = 0; g4 < 4; ++g4) {
      u32x2 ov; ov.x = pk2(accO[db][4 * g4 + 0], accO[db][4 * g4 + 1]); ov.y = pk2(accO[db][4 * g4 + 2], accO[db][4 * g4 + 3]);
      *(u32x2*)(Ot + (32 * wave + r) * 136 + 32 * db + 8 * g4 + 4 * h) = ov;
    }
  __syncthreads();
  int tid2 = tid; asm volatile("" : "+v"(tid2));
#pragma unroll
  for (int i = 0; i < 8; ++i) {
    const int c = tid2 + 256 * i, row = c >> 4, ch = c & 15;
    *(u32x4*)(opart + ((size_t)(tok0 + (unsigned)(i0 + row)) * 1024 + (unsigned)(hc * 128 + ch * 8))) = *(const u32x4*)(Ot + row * 136 + ch * 8);
  }
}

DI void diff_combine(const u16* __restrict__ z, const u16* __restrict__ opart, const float* __restrict__ mlpart, int nparts, float lam, float outscale,
                     const float* __restrict__ subg, u16* __restrict__ y) {
  constexpr int ZS = OCOLS_PAD;
  const int tid = opaque_tid(); const int lane = tid & 63, gw = blockIdx.x * 4 + (tid >> 6), nw = gridDim.x * 4;
  const int hcl = lane >> 3;
  for (int tok = gw; tok < TOK; tok += nw) {
    float o[16];
#pragma unroll
    for (int i = 0; i < 16; ++i) o[i] = 0.f;
#pragma unroll
    for (int st = 0; st < 2; ++st) {
      float M = -1e30f;
      for (int pt = 0; pt < nparts; ++pt) M = fmaxf(M, mlpart[(((size_t)(pt * 2 + st) * TOK + tok) * 8 + hcl) * 2]);
      float L = 0.f; float acc[16];
#pragma unroll
      for (int i = 0; i < 16; ++i) acc[i] = 0.f;
      for (int pt = 0; pt < nparts; ++pt) {
        const size_t base = (size_t)(pt * 2 + st) * TOK + tok;
        const float2 mlv = *(const float2*)(mlpart + (base * 8 + hcl) * 2);
        const float w = fexp2(mlv.x - M);
        L += mlv.y * w;
        const u32x4 a = *(const u32x4*)(opart + base * 1024 + lane * 16), b = *(const u32x4*)(opart + base * 1024 + lane * 16 + 8);
        acc[0] += w * bflo(a.x); acc[1] += w * bfhi(a.x); acc[2] += w * bflo(a.y); acc[3] += w * bfhi(a.y);
        acc[4] += w * bflo(a.z); acc[5] += w * bfhi(a.z); acc[6] += w * bflo(a.w); acc[7] += w * bfhi(a.w);
        acc[8] += w * bflo(b.x); acc[9] += w * bfhi(b.x); acc[10] += w * bflo(b.y); acc[11] += w * bfhi(b.y);
        acc[12] += w * bflo(b.z); acc[13] += w * bfhi(b.z); acc[14] += w * bflo(b.w); acc[15] += w * bfhi(b.w);
      }
      const float sc = (st == 0 ? 1.f : -lam) / L;
#pragma unroll
      for (int i = 0; i < 16; ++i) o[i] += acc[i] * sc;
    }
    float ss = 0.f;
#pragma unroll
    for (int i = 0; i < 16; ++i) ss += o[i] * o[i];
    ss += shx(ss, 1, lane); ss += shx(ss, 2, lane); ss += shx(ss, 4, lane);
    const float rs = rsqrtf(ss * (1.f / 128.f) + 1e-6f) * outscale;
    const int d0 = (lane & 7) * 16;
    const u32x4 ga = *(const u32x4*)(z + (size_t)tok * ZS + 3072 + lane * 16), gb = *(const u32x4*)(z + (size_t)tok * ZS + 3072 + lane * 16 + 8);
    const f32x4 s0 = *(const f32x4*)(subg + d0), s1 = *(const f32x4*)(subg + d0 + 4), s2 = *(const f32x4*)(subg + d0 + 8), s3 = *(const f32x4*)(subg + d0 + 12);
    u32x4 oa, ob;
    oa.x = pk2(o[0] * rs * s0.x * silu(bflo(ga.x)), o[1] * rs * s0.y * silu(bfhi(ga.x)));
    oa.y = pk2(o[2] * rs * s0.z * silu(bflo(ga.y)), o[3] * rs * s0.w * silu(bfhi(ga.y)));
    oa.z = pk2(o[4] * rs * s1.x * silu(bflo(ga.z)), o[5] * rs * s1.y * silu(bfhi(ga.z)));
    oa.w = pk2(o[6] * rs * s1.z * silu(bflo(ga.w)), o[7] * rs * s1.w * silu(bfhi(ga.w)));
    ob.x = pk2(o[8] * rs * s2.x * silu(bflo(gb.x)), o[9] * rs * s2.y * silu(bfhi(gb.x)));
    ob.y = pk2(o[10] * rs * s2.z * silu(bflo(gb.y)), o[11] * rs * s2.w * silu(bfhi(gb.y)));
    ob.z = pk2(o[12] * rs * s3.x * silu(bflo(gb.z)), o[13] * rs * s3.y * silu(bfhi(gb.z)));
    ob.w = pk2(o[14] * rs * s3.z * silu(bflo(gb.w)), o[15] * rs * s3.w * silu(bfhi(gb.w)));
    *(u32x4*)(y + (size_t)tok * YW + lane * 16) = oa;
    *(u32x4*)(y + (size_t)tok * YW + lane * 16 + 8) = ob;
  }
}

DI void gla_d1(const u16* __restrict__ z, unsigned tok0, int cn, int hd, int dir, unsigned item, const float* __restrict__ Wg, const float* __restrict__ bg,
               float* __restrict__ oout, u16* __restrict__ qebuf, float* __restrict__ kvbuf, float* __restrict__ decbuf, char* smem) {
  constexpr unsigned ZS = OCOLS_PAD;
  float* rank = (float*)smem;
  float* tots = rank + 1024;
  float* decay = tots + 256;
  u16* QE = (u16*)(smem + 5632);
  u16* KE = QE + 64 * 136;
  u16* KSt = KE + 64 * 136;
  u16* Vt = KSt + 128 * 68;
  u16* P = KE;
  const int tid = opaque_tid(), lane = tid & 63, wave = tid >> 6, r = lane & 31, h = lane >> 5;
  const int kd = tid & 127, th = tid >> 7;
  float wg[16];
#pragma unroll
  for (int i = 0; i < 16; ++i) wg[i] = Wg[(dir * 16 + i) * 512 + hd * 128 + kd];
  const float bias = bg[dir * 512 + hd * 128 + kd];
  const float qscale = 0.08838834764831845f;
  const int cbase = (int)tok0 + cn * 64 + (dir ? 63 : 0);
  const int sgn = dir ? -1 : 1;
  __syncthreads();
  {
    const int p = tid >> 2, r4 = (tid & 3) * 4;
    const u32x2 rv = *(const u32x2*)(z + ((unsigned)(cbase + sgn * p) * ZS + 6144u + (unsigned)(dir * 16 + r4)));
    f32x4 f; f.x = bflo(rv.x); f.y = bfhi(rv.x); f.z = bflo(rv.y); f.w = bfhi(rv.y);
    *(f32x4*)(rank + p * 16 + r4) = f;
  }
  __syncthreads();
  float run = 0.f;
#pragma unroll 4
  for (int j = 0; j < 32; ++j) {
    const int p = 32 * th + j;
    const f32x4* rp = (const f32x4*)(rank + p * 16);
    float acc = bias;
#pragma unroll
    for (int q4 = 0; q4 < 4; ++q4) {
      const f32x4 rv = rp[q4];
      acc += rv.x * wg[4 * q4 + 0] + rv.y * wg[4 * q4 + 1] + rv.z * wg[4 * q4 + 2] + rv.w * wg[4 * q4 + 3];
    }
    const float ls = (fminf(acc, 0.f) - __logf(1.f + __expf(-fabsf(acc)))) * (1.f / 16.f);
    run += ls;
    const unsigned lu = __float_as_uint(ls);
    QE[p * 136 + kd] = (u16)(lu & 0xffffu); KE[p * 136 + kd] = (u16)(lu >> 16);
  }
  tots[th * 128 + kd] = run;
  __syncthreads();
  const float t0 = tots[kd], t1 = tots[128 + kd];
  const float blast = t0 + t1;
  const float dec = __expf(blast);
  if (th == 0) { decay[kd] = dec; decbuf[item * 128u + (unsigned)kd] = dec; }
  float b = th ? t0 : 0.f;
  const u16* __restrict__ zc = z + (hd * 128 + kd);
#pragma unroll 16
  for (int j = 0; j < 32; ++j) {
    const int p = 32 * th + j;
    const float laj = __uint_as_float((unsigned)QE[p * 136 + kd] | ((unsigned)KE[p * 136 + kd] << 16));
    b += laj;
    const float e = __expf(b), ie = __expf(-b);
    const unsigned zo = (unsigned)(cbase + sgn * p) * ZS;
    const float q = bf2f(zc[zo + 4096u]), k = bf2f(zc[zo + 4608u]);
    QE[p * 136 + kd] = f2bf(q * e * qscale);
    const float ke = k * ie;
    KE[p * 136 + kd] = f2bf(ke);
    KSt[kd * 68 + p] = f2bf(ke * dec);
    Vt[kd * 68 + p] = zc[zo + 5120u];
  }
  __syncthreads();
#pragma unroll
  for (int i = 0; i < 4; ++i) {
    const int c = tid + 256 * i, row = c >> 4, ch = c & 15;
    *(u32x4*)(qebuf + (item * 8192u + (unsigned)(row * 128 + ch * 8))) = *(const u32x4*)(QE + row * 136 + ch * 8);
  }
  {
    const int sb = wave & 1, tb = wave >> 1;
    f32x16 s1 = zero16();
#pragma unroll
    for (int ks = 0; ks < 8; ++ks) {
      const bf16x8 a = *(const bf16x8*)(KE + (32 * sb + r) * 136 + 16 * ks + 8 * h);
      const bf16x8 bq = *(const bf16x8*)(QE + (32 * tb + r) * 136 + 16 * ks + 8 * h);
      s1 = MFMA(a, bq, s1);
    }
    __syncthreads();
    const int tp = 32 * tb + r;
#pragma unroll
    for (int g4 = 0; g4 < 4; ++g4) {
      const int s0 = 32 * sb + 8 * g4 + 4 * h;
      float v[4];
#pragma unroll
      for (int e = 0; e < 4; ++e) { const int sp = s0 + e; const bool keep = dir ? (sp < tp) : (sp <= tp); v[e] = keep ? s1[4 * g4 + e] : 0.f; }
      u32x2 pv; pv.x = pk2(v[0], v[1]); pv.y = pk2(v[2], v[3]);
      *(u32x2*)(P + tp * 72 + s0) = pv;
    }
  }
  __syncthreads();
  bf16x8 vfn[4];
#pragma unroll
  for (int ks = 0; ks < 4; ++ks) {
    const u16* vr = Vt + (32 * wave + r) * 68 + 16 * ks + 8 * h;
    vfn[ks] = cat8(*(const bf16x4*)vr, *(const bf16x4*)(vr + 4));
  }
  f32x16 o0 = zero16(), o1 = zero16();
#pragma unroll
  for (int ks = 0; ks < 4; ++ks) {
    const bf16x8 a0 = *(const bf16x8*)(P + (r) * 72 + 16 * ks + 8 * h);
    const bf16x8 a1 = *(const bf16x8*)(P + (32 + r) * 72 + 16 * ks + 8 * h);
    o0 = MFMA(a0, vfn[ks], o0); o1 = MFMA(a1, vfn[ks], o1);
  }
  {
    float* od = oout + (hd * 128 + 32 * wave + r);
#pragma unroll
    for (int e = 0; e < 16; ++e) {
      const int tp = 8 * (e >> 2) + 4 * h + (e & 3);
      od[(unsigned)(cbase + sgn * tp) * 512u] = o0[e];
      od[(unsigned)(cbase + sgn * (32 + tp)) * 512u] = o1[e];
    }
  }
#pragma unroll
  for (int kb = 0; kb < 4; ++kb) {
    f32x16 kv = zero16();
#pragma unroll
    for (int ks = 0; ks < 4; ++ks) {
      const u16* kr = KSt + (32 * kb + r) * 68 + 16 * ks + 8 * h;
      const bf16x8 a = cat8(*(const bf16x4*)kr, *(const bf16x4*)(kr + 4));
      kv = MFMA(a, vfn[ks], kv);
    }
#pragma unroll
    for (int g4 = 0; g4 < 4; ++g4) {
      f32x4 v4; v4.x = kv[4 * g4 + 0]; v4.y = kv[4 * g4 + 1]; v4.z = kv[4 * g4 + 2]; v4.w = kv[4 * g4 + 3];
      *(f32x4*)(kvbuf + (item * 16384u + (unsigned)((((wave * 4 + kb) * 4 + g4) * 64 + lane) * 4))) = v4;
    }
  }
}

DI void gla_d2(int nchunk, unsigned tok0, int hd, int dir, unsigned item0, const u16* __restrict__ qebuf, const float* __restrict__ kvbuf,
               const float* __restrict__ decbuf, float* __restrict__ oint, char* smem) {
  u16* QE = (u16*)smem;
  float* decay = (float*)(smem + 17408);
  const int tid = opaque_tid(), lane = tid & 63, wave = tid >> 6, r = lane & 31, h = lane >> 5;
  __builtin_amdgcn_s_setprio(2);
  f32x16 S[4] = {zero16(), zero16(), zero16(), zero16()};
  const int sgn = dir ? -1 : 1;
  u32x4 qst[4]; float dst = 0.f;
  {
    const unsigned it0 = item0 + (unsigned)(dir ? nchunk - 1 : 0);
#pragma unroll
    for (int i = 0; i < 4; ++i) qst[i] = *(const u32x4*)(qebuf + (it0 * 8192u + (unsigned)((tid + 256 * i) * 8)));
    if (tid < 128) dst = decbuf[it0 * 128u + (unsigned)tid];
  }
#pragma unroll 1
  for (int c = 0; c < nchunk; ++c) {
    const int cn = dir ? nchunk - 1 - c : c;
    const unsigned item = item0 + (unsigned)cn;
    const int cbase = (int)tok0 + cn * 64 + (dir ? 63 : 0);
    __syncthreads();
#pragma unroll
    for (int i = 0; i < 4; ++i) { const int cc = tid + 256 * i; *(u32x4*)(QE + (cc >> 4) * 136 + (cc & 15) * 8) = qst[i]; }
    if (tid < 128) decay[tid] = dst;
    __syncthreads();
    if (c + 1 < nchunk) {
      const unsigned itn = item0 + (unsigned)(dir ? cn - 1 : cn + 1);
#pragma unroll
      for (int i = 0; i < 4; ++i) qst[i] = *(const u32x4*)(qebuf + (itn * 8192u + (unsigned)((tid + 256 * i) * 8)));
      if (tid < 128) dst = decbuf[itn * 128u + (unsigned)tid];
    }
    f32x4 kvr[16];
#pragma unroll
    for (int i = 0; i < 16; ++i) kvr[i] = *(const f32x4*)(kvbuf + (item * 16384u + (unsigned)(((wave * 16 + i) * 64 + lane) * 4)));
    f32x16 o0 = zero16(), o1 = zero16();
#pragma unroll
    for (int kb = 0; kb < 4; ++kb)
#pragma unroll
      for (int s2 = 0; s2 < 2; ++s2) {
        u32x4 pw;
        pw.x = pk2(S[kb][8 * s2 + 0], S[kb][8 * s2 + 1]); pw.y = pk2(S[kb][8 * s2 + 2], S[kb][8 * s2 + 3]);
        pw.z = pk2(S[kb][8 * s2 + 4], S[kb][8 * s2 + 5]); pw.w = pk2(S[kb][8 * s2 + 6], S[kb][8 * s2 + 7]);
        const bf16x8 sf = __builtin_bit_cast(bf16x8, pw);
        const u16* qr0 = QE + (r) * 136 + 32 * kb + 16 * s2 + 4 * h;
        const u16* qr1 = QE + (32 + r) * 136 + 32 * kb + 16 * s2 + 4 * h;
        const bf16x8 a0 = cat8(*(const bf16x4*)qr0, *(const bf16x4*)(qr0 + 8));
        const bf16x8 a1 = cat8(*(const bf16x4*)qr1, *(const bf16x4*)(qr1 + 8));
        o0 = MFMA(a0, sf, o0); o1 = MFMA(a1, sf, o1);
      }
    {
      float* od = oint + (hd * 128 + 32 * wave + r);
#pragma unroll
      for (int e = 0; e < 16; ++e) {
        const int tp = 8 * (e >> 2) + 4 * h + (e & 3);
        od[(unsigned)(cbase + sgn * tp) * 512u] = o0[e];
        od[(unsigned)(cbase + sgn * (32 + tp)) * 512u] = o1[e];
      }
    }
#pragma unroll
    for (int kb = 0; kb < 4; ++kb)
#pragma unroll
      for (int g4 = 0; g4 < 4; ++g4) {
        const f32x4 dv = *(const f32x4*)(decay + 32 * kb + 8 * g4 + 4 * h);
        const f32x4 kq = kvr[kb * 4 + g4];
        S[kb][4 * g4 + 0] = S[kb][4 * g4 + 0] * dv.x + kq.x; S[kb][4 * g4 + 1] = S[kb][4 * g4 + 1] * dv.y + kq.y;
        S[kb][4 * g4 + 2] = S[kb][4 * g4 + 2] * dv.z + kq.z; S[kb][4 * g4 + 3] = S[kb][4 * g4 + 3] * dv.w + kq.w;
      }
  }
  __builtin_amdgcn_s_setprio(0);
}

DI void even_merge(const u16* __restrict__ z, const float* __restrict__ lse, u16* __restrict__ y) {
  constexpr int ZS = ECOLS;
  const int nthr = gridDim.x * NTHR;
  for (int it = blockIdx.x * NTHR + opaque_tid(); it < TOK * 64; it += nthr) {
    const int tok = it >> 6, ch = it & 63, hh = ch >> 3, d0 = (ch & 7) * 8;
    const float l0 = lse[tok * 24 + hh], l1 = lse[tok * 24 + 8 + hh], l2 = lse[tok * 24 + 16 + hh];
    const float mx = fmaxf(l0, fmaxf(l1, l2));
    float w0 = fexp2(l0 - mx), w1 = fexp2(l1 - mx), w2 = fexp2(l2 - mx);
    const float inv = 1.f / (w0 + w1 + w2); w0 *= inv; w1 *= inv; w2 *= inv;
    const u16* zr = z + (size_t)tok * ZS;
    const u32x4 a = *(const u32x4*)(zr + 2560 + hh * 64 + d0);
    const u32x4 b = *(const u32x4*)(zr + 2560 + 512 + hh * 64 + d0);
    const u32x4 c = *(const u32x4*)(zr + 2560 + 1024 + hh * 64 + d0);
    const u32x4 g = *(const u32x4*)(zr + 7168 + hh * 64 + d0);
    u32x4 o;
    o.x = pk2((w0 * bflo(a.x) + w1 * bflo(b.x) + w2 * bflo(c.x)) * silu(bflo(g.x)), (w0 * bfhi(a.x) + w1 * bfhi(b.x) + w2 * bfhi(c.x)) * silu(bfhi(g.x)));
    o.y = pk2((w0 * bflo(a.y) + w1 * bflo(b.y) + w2 * bflo(c.y)) * silu(bflo(g.y)), (w0 * bfhi(a.y) + w1 * bfhi(b.y) + w2 * bfhi(c.y)) * silu(bfhi(g.y)));
    o.z = pk2((w0 * bflo(a.z) + w1 * bflo(b.z) + w2 * bflo(c.z)) * silu(bflo(g.z)), (w0 * bfhi(a.z) + w1 * bfhi(b.z) + w2 * bfhi(c.z)) * silu(bfhi(g.z)));
    o.w = pk2((w0 * bflo(a.w) + w1 * bflo(b.w) + w2 * bflo(c.w)) * silu(bflo(g.w)), (w0 * bfhi(a.w) + w1 * bfhi(b.w) + w2 * bfhi(c.w)) * silu(bfhi(g.w)));
    *(u32x4*)(y + (size_t)tok * YW + 1024 + hh * 64 + d0) = o;
  }
}
DI void odd_merge(const u16* __restrict__ z, const float* __restrict__ of, const float* __restrict__ ob, const float* __restrict__ oif, const float* __restrict__ oib, const float* __restrict__ glag, u16* __restrict__ y) {
  constexpr int ZS = OCOLS_PAD;
  const int tid = opaque_tid(); const int lane = tid & 63, gw = blockIdx.x * 4 + (tid >> 6), nw = gridDim.x * 4;
  for (int tok = gw; tok < TOK; tok += nw) {
    const f32x4* pf = (const f32x4*)(of + (size_t)tok * 512 + lane * 8);
    const f32x4* pb = (const f32x4*)(ob + (size_t)tok * 512 + lane * 8);
    float v[8];
    { const f32x4* qf = (const f32x4*)(oif + (size_t)tok * 512 + lane * 8);
      const f32x4* qb = (const f32x4*)(oib + (size_t)tok * 512 + lane * 8);
      const f32x4 a = pf[0] + pb[0] + qf[0] + qb[0], b = pf[1] + pb[1] + qf[1] + qb[1];
      v[0] = a.x; v[1] = a.y; v[2] = a.z; v[3] = a.w; v[4] = b.x; v[5] = b.y; v[6] = b.z; v[7] = b.w; }
    float ss = 0.f;
#pragma unroll
    for (int i = 0; i < 8; ++i) ss += v[i] * v[i];
    ss += shx(ss, 1, lane); ss += shx(ss, 2, lane); ss += shx(ss, 4, lane); ss += shx(ss, 8, lane);
    const float rs = rsqrtf(ss * (1.f / 128.f) + 1e-6f);
    const int vd0 = (lane & 15) * 8;
    const f32x4 g0 = *(const f32x4*)(glag + vd0), g1 = *(const f32x4*)(glag + vd0 + 4);
    const u32x4 gt = *(const u32x4*)(z + (size_t)tok * ZS + 5632 + lane * 8);
    u32x4 o;
    o.x = pk2(v[0] * rs * g0.x * silu(bflo(gt.x)), v[1] * rs * g0.y * silu(bfhi(gt.x)));
    o.y = pk2(v[2] * rs * g0.z * silu(bflo(gt.y)), v[3] * rs * g0.w * silu(bfhi(gt.y)));
    o.z = pk2(v[4] * rs * g1.x * silu(bflo(gt.z)), v[5] * rs * g1.y * silu(bfhi(gt.z)));
    o.w = pk2(v[6] * rs * g1.z * silu(bflo(gt.w)), v[7] * rs * g1.w * silu(bfhi(gt.w)));
    *(u32x4*)(y + (size_t)tok * YW + 1024 + lane * 8) = o;
  }
}


#define XB_TMO      128
#define XB_XCNT(j)  (256  + 64 * (j))
#define XB_XSUB(j)  (1280 + 64 * (j))
#define XB_XGEN(j)  (2304 + 64 * (j))
#define XB_TOP      3328
#define XB_TOPGEN   3392
#define XCD_BAR_WORDS 3456
#define XB_SPIN_CAP (1u << 22)
#define LAS __attribute__((address_space(3)))
DI unsigned xb_ld(unsigned* p)              { return __hip_atomic_load(p, __ATOMIC_RELAXED, __HIP_MEMORY_SCOPE_AGENT); }
DI unsigned xb_add(unsigned* p, unsigned v) { return __hip_atomic_fetch_add(p, v, __ATOMIC_RELAXED, __HIP_MEMORY_SCOPE_AGENT); }
DI unsigned xb_xcc_id() { return (unsigned)__builtin_amdgcn_s_getreg((3 << 11) | 20) & 0xFu; }
#define XB_SPIN(cond, bar) do { unsigned _sp = 0; while (cond) { __builtin_amdgcn_s_sleep(1); \
    if ((++_sp & 255u) == 0u) { if (xb_ld(&(bar)[XB_TMO])) break; if (_sp > XB_SPIN_CAP) { atomicAdd(&(bar)[XB_TMO], 1u); break; } } } } while (0)
struct XcdBarrier { unsigned* bar; unsigned x; volatile LAS unsigned* st; };
DI XcdBarrier xcd_barrier_post(unsigned* bar, volatile LAS unsigned* st) {
  XcdBarrier b; b.bar = bar; b.x = xb_xcc_id(); b.st = st;
  if (threadIdx.x == 0) (void)xb_add(&bar[XB_XCNT(b.x)], 1u);
  return b;
}
DI void xcd_barrier_complete(unsigned* bar, unsigned x, unsigned& nloc, unsigned& nx) {
  const unsigned G = gridDim.x * gridDim.y * gridDim.z;
  unsigned sum, cnt, mine, sp = 0u;
  for (;;) {
    sum = 0u; cnt = 0u; mine = 0u;
#pragma unroll
    for (unsigned j = 0; j < 16; ++j) { const unsigned c = xb_ld(&bar[XB_XCNT(j)]); sum += c; cnt += (c > 0u) ? 1u : 0u; mine = (j == x) ? c : mine; }
    if (sum == G) break;
    __builtin_amdgcn_s_sleep(1);
    if ((++sp & 255u) == 0u) { if (xb_ld(&bar[XB_TMO])) break; if (sp > XB_SPIN_CAP) { atomicAdd(&bar[XB_TMO], 1u); break; } }
  }
  nloc = mine > 0u ? mine : 1u; nx = cnt > 0u ? cnt : 1u;
}
DI void xcd_barrier(const XcdBarrier& b) {
  asm volatile("s_waitcnt vmcnt(0)" ::: "memory");
  __syncthreads();
  if (threadIdx.x == 0) {
    unsigned* bar = b.bar;
    __builtin_amdgcn_s_waitcnt(0);
    unsigned nloc = b.st[0], nx = b.st[1];
    if (nloc == 0u) { xcd_barrier_complete(bar, b.x, nloc, nx); b.st[0] = nloc; b.st[1] = nx; }
    const unsigned old = xb_add(&bar[XB_XSUB(b.x)], 1u);
    const unsigned gen = old / nloc;
    if (old + 1u == (gen + 1u) * nloc) {
      __builtin_amdgcn_fence(__ATOMIC_RELEASE, "agent");
      asm volatile("s_waitcnt vmcnt(0)" ::: "memory");
      const unsigned og = xb_add(&bar[XB_TOP], 1u);
      const unsigned tg = og / nx;
      if (og + 1u == (tg + 1u) * nx) xb_add(&bar[XB_TOPGEN], 1u);
      else XB_SPIN(xb_ld(&bar[XB_TOPGEN]) == tg, bar);
      __builtin_amdgcn_fence(__ATOMIC_ACQUIRE, "agent");
      xb_add(&bar[XB_XGEN(b.x)], 1u);
      asm volatile("s_waitcnt vmcnt(0)" ::: "memory");
    } else {
      XB_SPIN(xb_ld(&bar[XB_XGEN(b.x)]) == gen, bar);
      __builtin_amdgcn_fence(__ATOMIC_ACQUIRE, "agent");
      asm volatile("s_waitcnt vmcnt(0)" ::: "memory");
    }
  }
  __syncthreads();
}

__global__ void __launch_bounds__(NTHR, 2) mega(Params p) {
  extern __shared__ __attribute__((aligned(16))) char smem[];
  cg::grid_group grid = cg::this_grid();
  __shared__ uint4 xb_words;
  if (threadIdx.x == 0) xb_words = make_uint4(0u, 0u, 0u, 0u);
  __syncthreads();
  const XcdBarrier xb = xcd_barrier_post(p.bar, (volatile LAS unsigned*)&xb_words);

  if (blockIdx.x == 0 && threadIdx.x < 64) p.ctr[threadIdx.x] = 0;
#pragma unroll
  for (int i = 0; i < 4; ++i) {
    const int j = i >> 1;
    if ((i & 1) == 0) prep_transpose(p.even_w_in + (size_t)j * DM * ECOLS, p.norm_g + i * DM, DM, ECOLS, ECOLS, p.wte_in + (size_t)j * ECOLS * DM, smem);
    else              prep_transpose(p.odd_w_in + (size_t)j * DM * OCOLS, p.norm_g + i * DM, DM, OCOLS, OCOLS_PAD, p.wto_in + (size_t)j * OCOLS_PAD * DM, smem);
    prep_transpose(((i & 1) ? p.odd_w_out : p.even_w_out) + (size_t)j * YW * DM, nullptr, YW, DM, DM, ((i & 1) ? p.wto_out : p.wte_out) + (size_t)j * DM * YW, smem);
  }
  grid.sync();

  for (int g = 0; g < NGROUP; ++g) {
    const int T = (g < 4) ? 2048 : 8192;
    const int nqb = T / 128;
    const float* xin = (g < 4) ? (p.x_prompt + (size_t)g * TOK * DM) : p.x_sample;
    float* xres = p.out + (size_t)g * TOK * DM;
#pragma unroll
    for (int layer = 0; layer < 4; ++layer) {
      const int j = layer >> 1;
      const float* xsrc = layer == 0 ? xin : xres;
      norm_rows(xsrc, p.hb);
      xcd_barrier(xb);
      int* ctr = p.ctr + g * 4 + layer;
      if ((layer & 1) == 0) {
        gemm_phase<0>(p.hb, DM, p.wte_in + (size_t)j * ECOLS * DM, DM, ECOLS / 128, p.z, ECOLS, nullptr, nullptr, nullptr, T, smem);
        xcd_barrier(xb);
        const int nA = 2048, nB = 3072;
        for (;;) {
          const int it = next_item(ctr, smem);
          if (it >= nA + nB) break;
          if (it < nA) {
            const int qb = it % nqb, hq = (it / nqb) & 15, b = it / (nqb * 16);
            const float slope = exp2f(-0.5f * (float)(hq + 1));
            const float sk = p.sink[j * 16 + hq] * LOG2E;
            band_item(p.z, (size_t)b * T, 1, 0, T, qb * 128, 128, hq * 64, 1024 + (hq >> 2) * 64, 1280 + (hq >> 2) * 64,
                      slope * LOG2E, sk, 1.f, 0, 1536 + hq * 64, p.y, hq * 64, nullptr, 0, smem);
          } else {
            const int i2 = it - nA, pr = i2 >> 10, rem = i2 & 1023;
            const int jj = rem % nqb, hh = (rem / nqb) & 7, b = rem / (nqb * 8);
            const int dil = pr == 0 ? 1 : (pr == 1 ? 4 : 16);
            const int res = jj % dil, gqb = jj / dil;
            const float slope = exp2f(-(float)(hh + 1));
            band_item(p.z, (size_t)b * T, dil, res, T / dil, gqb * 128, 64, 2560 + pr * 512 + hh * 64, 4096 + pr * 512 + hh * 64,
                      5632 + pr * 512 + hh * 64, slope * (float)dil * LOG2E, -1e30f, 0.f, 1, 0, nullptr, 0, p.lse, pr * 8 + hh, smem);
          }
        }
        xcd_barrier(xb);
        even_merge(p.z, p.lse, p.y);
        xcd_barrier(xb);
      } else {
        gemm_phase<0>(p.hb, DM, p.wto_in + (size_t)j * OCOLS_PAD * DM, DM, OCOLS_PAD / 128, p.z, OCOLS_PAD, nullptr, nullptr, p.vtb, T, smem);
        xcd_barrier(xb);
        const int nseq = TOK / T;
        const int nparts = (T > 2048) ? 2 : 1;
        const int nD = nseq * 8, nC = 2048 * nparts;
        const int nchunk = T / 64;
        for (;;) {
          const int it = next_item(ctr, smem);
          if (it >= 2048) break;
          const int cn = it % nchunk, cid = it / nchunk;
          const int dir = cid & 1, hd = (cid >> 1) & 3, b = cid >> 3;
          gla_d1(p.z, (unsigned)(b * T), cn, hd, dir, (unsigned)it, p.gate2 + (size_t)j * 2 * 16 * 512, p.bgate + j * 2 * 512,
                 dir ? p.ob : p.of, p.qebuf, p.kvbuf, p.decbuf, smem);
        }
        xcd_barrier(xb);
        const float lam_init = uni(0.8f - 0.6f * expf(-0.3f * (float)layer));
        float lam;
        {
          const float* lp = p.diff_lambda + j * 256;
          float s01 = 0.f, s23 = 0.f;
          for (int i = 0; i < 64; ++i) { s01 += lp[i] * lp[64 + i]; s23 += lp[128 + i] * lp[192 + i]; }
          lam = uni(expf(s01) - expf(s23) + lam_init);
        }
        for (;;) {
          const int it = next_item(ctr + 32, smem);
          if (it >= nD + nC) break;
          if (it < nD) {
            const int dir = it & 1, hd = (it >> 1) & 3, b = it >> 3;
            gla_d2(nchunk, (unsigned)(b * T), hd, dir, (unsigned)(it * nchunk), p.qebuf, p.kvbuf, p.decbuf, dir ? p.oib : p.oif, smem);
          } else {
            const int i2 = it - nD;
            const int pt = i2 % nparts, st = (i2 / nparts) & 1, i3 = i2 / (2 * nparts);
            const int qb = i3 % nqb, hc = (i3 / nqb) & 7, b = i3 / (nqb * 8);
            const float slope = exp2f(-(float)(hc + 1));
            const int klen = T / nparts;
            diff_item(p.z, p.vtb, (unsigned)(b * T), T, hc, qb * 128, st, pt * klen, (pt + 1) * klen, uni(slope * LOG2E),
                      p.opart + (size_t)(pt * 2 + st) * TOK * 1024, p.mlpart + (size_t)(pt * 2 + st) * TOK * 16, smem);
          }
        }
        xcd_barrier(xb);
        odd_merge(p.z, p.of, p.ob, p.oif, p.oib, p.gla_g + j * 128, p.y);
        diff_combine(p.z, p.opart, p.mlpart, nparts, lam, 1.f - lam_init, p.subln_g + j * 128, p.y);
        xcd_barrier(xb);
      }
      gemm_phase<1>(p.y, YW, ((layer & 1) ? p.wto_out : p.wte_out) + (size_t)j * DM * YW, YW, DM / 128, nullptr, 0, xsrc, xres, nullptr, T, smem);
      xcd_barrier(xb);
    }
    final_norm_rows(xres, p.final_g);
  }
}

extern "C" void kernel_launch(void* const* d_in, const int* in_sizes, int n_in, void* d_out, int out_size, void* d_ws, size_t ws_size,
                              hipStream_t stream) {
  static int grid_blocks = 0;
  if (!grid_blocks) {
    int dev = 0, cus = 0, per_cu = 0;
    hipGetDevice(&dev);
    hipDeviceGetAttribute(&cus, hipDeviceAttributeMultiprocessorCount, dev);
    hipFuncSetAttribute((const void*)mega, hipFuncAttributeMaxDynamicSharedMemorySize, SMEM_BYTES);
    hipOccupancyMaxActiveBlocksPerMultiprocessor(&per_cu, mega, NTHR, SMEM_BYTES);
    if (per_cu > 2) per_cu = 2;
    if (per_cu < 1) per_cu = 1;
    grid_blocks = cus * per_cu;
  }
  Params p{};
  p.x_prompt = (const float*)d_in[0]; p.x_sample = (const float*)d_in[1]; p.norm_g = (const float*)d_in[2]; p.final_g = (const float*)d_in[3];
  p.even_w_in = (const float*)d_in[4]; p.even_w_out = (const float*)d_in[5]; p.sink = (const float*)d_in[6];
  p.odd_w_in = (const float*)d_in[7]; p.odd_w_out = (const float*)d_in[8]; p.diff_lambda = (const float*)d_in[9];
  p.subln_g = (const float*)d_in[10]; p.gate2 = (const float*)d_in[11]; p.bgate = (const float*)d_in[12]; p.gla_g = (const float*)d_in[13];
  p.out = (float*)d_out;
  char* w = (char*)d_ws; size_t off = 0;
  auto take = [&](size_t bytes) { char* q = w + off; off += (bytes + 255) & ~(size_t)255; return q; };
  p.wte_in = (u16*)take((size_t)2 * ECOLS * DM * 2);
  p.wto_in = (u16*)take((size_t)2 * OCOLS_PAD * DM * 2);
  p.wte_out = (u16*)take((size_t)2 * DM * YW * 2);
  p.wto_out = (u16*)take((size_t)2 * DM * YW * 2);
  p.hb = (u16*)take((size_t)TOK * DM * 2);
  p.z = (u16*)take((size_t)TOK * ECOLS * 2);
  p.y = (u16*)take((size_t)TOK * YW * 2);
  p.lse = (float*)take((size_t)TOK * 24 * 4);
  p.of = (float*)take((size_t)TOK * 512 * 4);
  p.ob = (float*)take((size_t)TOK * 512 * 4);
  p.oif = (float*)take((size_t)TOK * 512 * 4);
  p.oib = (float*)take((size_t)TOK * 512 * 4);
  p.vtb = (u16*)take((size_t)TOK * 1024 * 2);
  p.opart = (u16*)take((size_t)4 * TOK * 1024 * 2);
  p.mlpart = (float*)take((size_t)4 * TOK * 16 * 4);
  p.qebuf = (u16*)take((size_t)2048 * 8192 * 2);
  p.kvbuf = (float*)take((size_t)2048 * 16384 * 4);
  p.decbuf = (float*)take((size_t)2048 * 128 * 4);
  p.ctr = (int*)take(512);
  p.bar = (unsigned*)take(XCD_BAR_WORDS * 4);
  (void)hipMemsetAsync(p.bar, 0, XCD_BAR_WORDS * 4, stream);
  void* args[] = {&p};
  hipError_t e = hipLaunchCooperativeKernel((const void*)mega, dim3(grid_blocks), dim3(NTHR), args, SMEM_BYTES, stream);
  if (e != hipSuccess) fprintf(stderr, "cooperative launch failed: %s (grid %d)\n", hipGetErrorString(e), grid_blocks);
}
```

```cpp
#include <hip/hip_runtime.h>
#include <hip/hip_cooperative_groups.h>
#include <cstdio>
namespace cg = cooperative_groups;

#define DI __device__ __forceinline__
typedef unsigned short u16;
typedef __attribute__((ext_vector_type(8))) short bf16x8;
typedef __attribute__((ext_vector_type(4))) short bf16x4;
typedef __attribute__((ext_vector_type(16))) float f32x16;
typedef __attribute__((ext_vector_type(2))) __bf16 bf2_t;
typedef __attribute__((ext_vector_type(2))) float f2_t;
typedef __attribute__((ext_vector_type(4))) unsigned u32x4;
typedef __attribute__((ext_vector_type(2))) unsigned u32x2;
typedef __attribute__((ext_vector_type(4))) float f32x4;
#define MFMA(a, b, c) __builtin_amdgcn_mfma_f32_32x32x16_bf16((a), (b), (c), 0, 0, 0)

constexpr int NTHR = 256;
constexpr int DM = 1024;
constexpr int TOK = 16384;
constexpr int NGROUP = 5;
constexpr int ECOLS = 7680;
constexpr int OCOLS = 6176;
constexpr int OCOLS_PAD = 6272;
constexpr int YW = 1536;
constexpr int SMEM_BYTES = 77824;
constexpr float LOG2E = 1.4426950408889634f;
constexpr float NEG_INF = -__builtin_inff();

struct Params {
  const float* x_prompt; const float* x_sample; const float* norm_g; const float* final_g;
  const float* even_w_in; const float* even_w_out; const float* sink; const float* odd_w_in; const float* odd_w_out;
  const float* diff_lambda; const float* subln_g; const float* gate2; const float* bgate; const float* gla_g;
  float* out;
  u16* wte_in; u16* wto_in; u16* wte_out; u16* wto_out;
  u16* hb; u16* z; u16* y;
  float* lse; float* of; float* ob; float* oif; float* oib; u16* vtb; u16* opart; float* mlpart; u16* qebuf; float* kvbuf; float* decbuf; int* ctr; unsigned* bar;
};

DI unsigned pk2(float a, float b) { f2_t v = {a, b}; bf2_t r = __builtin_convertvector(v, bf2_t); return __builtin_bit_cast(unsigned, r); }
DI u16 f2bf(float a) { return (u16)(pk2(a, 0.f) & 0xffffu); }
DI float bf2f(u16 v) { return __uint_as_float(((unsigned)v) << 16); }
DI float bflo(unsigned v) { return __uint_as_float(v << 16); }
DI float bfhi(unsigned v) { return __uint_as_float(v & 0xffff0000u); }
DI float fexp2(float x) { return __builtin_amdgcn_exp2f(x); }
DI float flog2(float x) { return __builtin_amdgcn_logf(x); }
DI float frcp(float x) { return __builtin_amdgcn_rcpf(x); }
DI float silu(float x) { return x * frcp(1.f + fexp2(-x * LOG2E)); }
DI float shx(float v, int m, int lane) { return __int_as_float(__builtin_amdgcn_ds_bpermute((lane ^ m) << 2, __float_as_int(v))); }
DI float wave_sum(float v, int lane) { for (int o = 32; o; o >>= 1) v += shx(v, o, lane); return v; }
DI bf16x8 cat8(bf16x4 lo, bf16x4 hi) { return __builtin_shufflevector(lo, hi, 0, 1, 2, 3, 4, 5, 6, 7); }
DI f32x16 zero16() { f32x16 z; for (int i = 0; i < 16; ++i) z[i] = 0.f; return z; }

DI float uni(float x) { return __int_as_float(__builtin_amdgcn_readfirstlane(__float_as_int(x))); }
DI int opaque_tid() { int t = threadIdx.x; asm volatile("" : "+v"(t)); return t; }

DI int next_item(int* ctr, char* smem) {
  int* sh = (int*)(smem + SMEM_BYTES - 16);
  __syncthreads();
  if (threadIdx.x == 0) *sh = atomicAdd(ctr, 1);
  __syncthreads();
  return *sh;
}

DI void prep_transpose(const float* __restrict__ src, const float* __restrict__ g, int R, int C, int Cpad, u16* __restrict__ dst, char* smem) {
  float* tl = (float*)smem;
  const int tcols = Cpad / 64, ntiles = (R / 64) * tcols;
  const int tid = opaque_tid(), cc = tid & 63, rr = tid >> 6;
  for (int tile = blockIdx.x; tile < ntiles; tile += gridDim.x) {
    const int r0 = (tile / tcols) * 64, c0 = (tile % tcols) * 64;
#pragma unroll
    for (int i = 0; i < 16; ++i) {
      const int row = i * 4 + rr, c = c0 + cc;
      float v = 0.f;
      if (c < C) { v = src[(size_t)(r0 + row) * C + c]; if (g) v *= g[r0 + row]; }
      tl[row * 65 + cc] = v;
    }
    __syncthreads();
#pragma unroll
    for (int i = 0; i < 16; ++i) {
      const int crow = i * 4 + rr;
      dst[(size_t)(c0 + crow) * R + r0 + cc] = f2bf(tl[cc * 65 + crow]);
    }
    __syncthreads();
  }
}

DI void norm_rows(const float* __restrict__ xin, u16* __restrict__ hb) {
  const int tid = opaque_tid(); const int lane = tid & 63, gw = blockIdx.x * 4 + (tid >> 6), nw = gridDim.x * 4;
  for (int row = gw; row < TOK; row += nw) {
    const f32x4* p = (const f32x4*)(xin + (size_t)row * DM);
    f32x4 v[4]; float ss = 0.f;
#pragma unroll
    for (int i = 0; i < 4; ++i) { v[i] = p[lane + 64 * i]; ss += v[i].x * v[i].x + v[i].y * v[i].y + v[i].z * v[i].z + v[i].w * v[i].w; }
    ss = wave_sum(ss, lane);
    const float rs = rsqrtf(ss * (1.f / DM) + 1e-6f);
#pragma unroll
    for (int i = 0; i < 4; ++i) {
      u32x2 o; o.x = pk2(v[i].x * rs, v[i].y * rs); o.y = pk2(v[i].z * rs, v[i].w * rs);
      *(u32x2*)(hb + (size_t)row * DM + (lane + 64 * i) * 4) = o;
    }
  }
}
DI void final_norm_rows(float* __restrict__ x, const float* __restrict__ g) {
  const int tid = opaque_tid(); const int lane = tid & 63, gw = blockIdx.x * 4 + (tid >> 6), nw = gridDim.x * 4;
  for (int row = gw; row < TOK; row += nw) {
    f32x4* p = (f32x4*)(x + (size_t)row * DM);
    const f32x4* gp = (const f32x4*)g;
    f32x4 v[4]; float ss = 0.f;
#pragma unroll
    for (int i = 0; i < 4; ++i) { v[i] = p[lane + 64 * i]; ss += v[i].x * v[i].x + v[i].y * v[i].y + v[i].z * v[i].z + v[i].w * v[i].w; }
    ss = wave_sum(ss, lane);
    const float rs = rsqrtf(ss * (1.f / DM) + 1e-6f);
#pragma unroll
    for (int i = 0; i < 4; ++i) {
      const f32x4 gg = gp[lane + 64 * i];
      f32x4 o; o.x = v[i].x * rs * gg.x; o.y = v[i].y * rs * gg.y; o.z = v[i].z * rs * gg.z; o.w = v[i].w * rs * gg.w;
      p[lane + 64 * i] = o;
    }
  }
}

template <int EPI>
DI void gemm_phase(const u16* __restrict__ A, int lda, const u16* __restrict__ Bt, int K, int ntn,
                   u16* __restrict__ zout, int ldz, const float* __restrict__ resid, float* __restrict__ xout, u16* __restrict__ vtout, int T, char* smem) {
  constexpr int LS = 72;
  u16* As = (u16*)smem;
  u16* Bs = As + 2 * 128 * LS;
  const int tid = opaque_tid(), lane = tid & 63, wave = tid >> 6;
  const int wm = wave >> 1, wn = wave & 1, r = lane & 31, h = lane >> 5;
  const int ntiles = (TOK / 128) * ntn, KT = K / 64;
  const int RN = (ntn % 6 == 0) ? 6 : ((ntn % 7 == 0) ? 7 : 8);
  const int rpr = ntn / RN, per = ntiles >> 3, nb8 = gridDim.x >> 3;
  for (int li = (int)(blockIdx.x >> 3); li < per; li += nb8) {
    const int ti = (int)(blockIdx.x & 7) * per + li;
    const int rect = ti / (8 * RN), within = ti - rect * (8 * RN);
    const int band = rect / rpr, rcol = rect - band * rpr;
    const int m0 = (band * 8 + (within & 7)) * 128, n0 = (rcol * RN + (within >> 3)) * 128;
    f32x16 acc[2][2];
#pragma unroll
    for (int i = 0; i < 2; ++i) for (int j = 0; j < 2; ++j) acc[i][j] = zero16();
    const int srow = lane >> 3, spos = lane & 7;
    const int ch_ = spos ^ ((4 * wave + (srow >> 1)) & 7);
    const u16* __restrict__ ag = A + (size_t)(m0 + 8 * wave + srow) * lda + ch_ * 8;
    const u16* __restrict__ bg = Bt + (size_t)(n0 + 8 * wave + srow) * K + ch_ * 8;
#define STAGE(BUF_, KT_) { _Pragma("unroll") for (int i = 0; i < 4; ++i) { \
      __builtin_amdgcn_global_load_lds((const unsigned*)(ag + (size_t)(32 * i) * lda + (KT_) * 64), (unsigned*)(smem + (BUF_) * 16384 + (4 * i + wave) * 1024), 16, 0, 0); \
      __builtin_amdgcn_global_load_lds((const unsigned*)(bg + (size_t)(32 * i) * K + (KT_) * 64), (unsigned*)(smem + 32768 + (BUF_) * 16384 + (4 * i + wave) * 1024), 16, 0, 0); } }
    __syncthreads();
    STAGE(0, 0);
    __syncthreads();
    const int ra_ = wm * 64 + r, rb_ = wn * 64 + r;
    const int fa_ = (ra_ >> 1) & 7, fb_ = (rb_ >> 1) & 7;
#pragma unroll 1
    for (int kt = 0; kt < KT; ++kt) {
      const int buf = kt & 1;
      if (kt + 1 < KT) STAGE(buf ^ 1, kt + 1);
      const char* ab = smem + buf * 16384 + ra_ * 128;
      const char* bb = smem + 32768 + buf * 16384 + rb_ * 128;
#pragma unroll
      for (int ks = 0; ks < 4; ++ks) {
        const int pa_ = ((2 * ks + h) ^ fa_) << 4, pb_ = ((2 * ks + h) ^ fb_) << 4;
        const bf16x8 a0 = *(const bf16x8*)(ab + pa_), a1 = *(const bf16x8*)(ab + 4096 + pa_);
        const bf16x8 b0 = *(const bf16x8*)(bb + pb_), b1 = *(const bf16x8*)(bb + 4096 + pb_);
        acc[0][0] = MFMA(a0, b0, acc[0][0]); acc[0][1] = MFMA(a0, b1, acc[0][1]);
        acc[1][0] = MFMA(a1, b0, acc[1][0]); acc[1][1] = MFMA(a1, b1, acc[1][1]);
      }
      __syncthreads();
    }
#undef STAGE
    if (EPI == 0 && vtout != nullptr && n0 >= 2048 && n0 < 3072) {
#pragma unroll
      for (int i = 0; i < 2; ++i)
#pragma unroll
        for (int j = 0; j < 2; ++j)
#pragma unroll
          for (int g4 = 0; g4 < 4; ++g4) {
            const int m = m0 + wm * 64 + i * 32 + 8 * g4 + 4 * h;
            const int n = n0 + wn * 64 + j * 32 + r;
            const int seq = m / T, t0_ = m - seq * T;
            const int g_ = (t0_ >> 2) & 3, t = (t0_ & ~15) | ((((g_ & 1) << 1) | (g_ >> 1)) << 2);
            u32x2 ov; ov.x = pk2(acc[i][j][4 * g4 + 0], acc[i][j][4 * g4 + 1]); ov.y = pk2(acc[i][j][4 * g4 + 2], acc[i][j][4 * g4 + 3]);
            *(u32x2*)(vtout + ((unsigned)(seq * 1024 + (n - 2048)) * (unsigned)T + (unsigned)t)) = ov;
          }
    } else
#pragma unroll
    for (int i = 0; i < 2; ++i)
#pragma unroll
      for (int j = 0; j < 2; ++j)
#pragma unroll
        for (int e = 0; e < 16; ++e) {
          const int m = m0 + wm * 64 + i * 32 + 8 * (e >> 2) + 4 * h + (e & 3);
          const int n = n0 + wn * 64 + j * 32 + r;
          if (EPI == 0) zout[(size_t)m * ldz + n] = f2bf(acc[i][j][e]);
          else xout[(size_t)m * DM + n] = resid[(size_t)m * DM + n] + acc[i][j][e];
        }
  }
}

DI void band_item(u16* __restrict__ z, size_t tok0, int dil, int res, int L, int i0, int R,
                  int qoff, int koff, int voff, float c2, float m_init, float l_init, int mode,
                  int goff, u16* __restrict__ y, int ycol, float* __restrict__ lse, int lidx, char* smem) {
  constexpr int ZS = ECOLS;
  u16* Ks = (u16*)smem;
  u16* Vs = Ks + 64 * 72;
  const int tid = opaque_tid(), lane = tid & 63, wave = tid >> 6, r = lane & 31, h = lane >> 5;
  const int q0 = i0 + 32 * wave, qi = q0 + r;
  const size_t qtok = tok0 + res + (size_t)qi * dil;
  bf16x8 qf[4];
#pragma unroll
  for (int ks = 0; ks < 4; ++ks) qf[ks] = *(const bf16x8*)(z + qtok * ZS + qoff + 16 * ks + 8 * h);
  f32x16 accO[2] = {zero16(), zero16()};
  float m = m_init, l = (h == 0) ? l_init : 0.f;
  const float scale2 = 0.125f * LOG2E;
  const int ntile = (128 + 2 * R) / 64;
  const int t_lo = (R - i0) > 0 ? (R - i0) / 64 : 0;
  int t_hi = (L - i0 + R) / 64; t_hi = (t_hi < ntile ? t_hi : ntile) - 1;
  const int lrow = tid >> 3, lch = tid & 7;
  u32x4 kr[2], vr[2];
  {
    const int kb = i0 - R + 64 * t_lo;
#pragma unroll
    for (int i = 0; i < 2; ++i) {
      const size_t ktok = tok0 + res + (size_t)(kb + lrow + 32 * i) * dil;
      kr[i] = *(const u32x4*)(z + ktok * ZS + koff + lch * 8);
      vr[i] = *(const u32x4*)(z + ktok * ZS + voff + lch * 8);
    }
  }
  for (int t = t_lo; t <= t_hi; ++t) {
    const int kb = i0 - R + 64 * t;
    __syncthreads();
#pragma unroll
    for (int i = 0; i < 2; ++i) {
      const int row = lrow + 32 * i;
      *(u32x4*)(Ks + row * 72 + lch * 8) = kr[i];
      *(u32x4*)(Vs + row * 96 + lch * 8) = vr[i];
    }
    __syncthreads();
    if (t < t_hi) {
#pragma unroll
      for (int i = 0; i < 2; ++i) {
        const size_t ktok = tok0 + res + (size_t)(kb + 64 + lrow + 32 * i) * dil;
        kr[i] = *(const u32x4*)(z + ktok * ZS + koff + lch * 8);
        vr[i] = *(const u32x4*)(z + ktok * ZS + voff + lch * 8);
      }
    }
    if (kb + 63 < q0 - R || kb > q0 + 31 + R) continue;
    f32x16 accS[2] = {zero16(), zero16()};
#pragma unroll
    for (int u = 0; u < 2; ++u)
#pragma unroll
      for (int ks = 0; ks < 4; ++ks) {
        const bf16x8 a = *(const bf16x8*)(Ks + (32 * u + r) * 72 + 16 * ks + 8 * h);
        accS[u] = MFMA(a, qf[ks], accS[u]);
      }
    float mx = NEG_INF;
    const float d0 = (float)(qi - kb - 4 * h), Rf = (float)R;
#pragma unroll
    for (int u = 0; u < 2; ++u)
#pragma unroll
      for (int e = 0; e < 16; ++e) {
        const float dd = fabsf(d0 - (float)(32 * u + 8 * (e >> 2) + (e & 3)));
        float sc = accS[u][e] * scale2 - c2 * dd;
        sc = (dd <= Rf) ? sc : NEG_INF;
        accS[u][e] = sc; mx = fmaxf(mx, sc);
      }
    mx = fmaxf(mx, shx(mx, 32, lane));
    const float mn = fmaxf(m, mx);
    const float alpha = fexp2(m - mn);
    m = mn;
    float ps = 0.f;
#pragma unroll
    for (int u = 0; u < 2; ++u)
#pragma unroll
      for (int e = 0; e < 16; ++e) { const float p = fexp2(accS[u][e] - mn); accS[u][e] = p; ps += p; }
    l = l * alpha + ps;
#pragma unroll
    for (int db = 0; db < 2; ++db)
#pragma unroll
      for (int e = 0; e < 16; ++e) accO[db][e] *= alpha;
    const int i16 = lane & 15;
    const unsigned lb = (unsigned)(size_t)Vs + (unsigned)((4 * h + (i16 >> 2)) * 192 + (16 * ((lane >> 4) & 1) + 4 * (i16 & 3)) * 2);
#pragma unroll
    for (int u = 0; u < 2; ++u) {
      bf16x4 vq[8];
      asm volatile(
        "ds_read_b64_tr_b16 %0, %8 offset:0\n\t"     "ds_read_b64_tr_b16 %1, %8 offset:1536\n\t"
        "ds_read_b64_tr_b16 %2, %8 offset:64\n\t"    "ds_read_b64_tr_b16 %3, %8 offset:1600\n\t"
        "ds_read_b64_tr_b16 %4, %8 offset:3072\n\t"  "ds_read_b64_tr_b16 %5, %8 offset:4608\n\t"
        "ds_read_b64_tr_b16 %6, %8 offset:3136\n\t"  "ds_read_b64_tr_b16 %7, %8 offset:4672\n\t"
        "s_waitcnt lgkmcnt(0)"
        : "=&v"(vq[0]), "=&v"(vq[1]), "=&v"(vq[2]), "=&v"(vq[3]), "=&v"(vq[4]), "=&v"(vq[5]), "=&v"(vq[6]), "=&v"(vq[7])
        : "v"(lb + (unsigned)(u * 6144)) : "memory");
#pragma unroll
      for (int s = 0; s < 2; ++s) {
        u32x4 pw;
        pw.x = pk2(accS[u][8 * s + 0], accS[u][8 * s + 1]); pw.y = pk2(accS[u][8 * s + 2], accS[u][8 * s + 3]);
        pw.z = pk2(accS[u][8 * s + 4], accS[u][8 * s + 5]); pw.w = pk2(accS[u][8 * s + 6], accS[u][8 * s + 7]);
        const bf16x8 pf = __builtin_bit_cast(bf16x8, pw);
#pragma unroll
        for (int db = 0; db < 2; ++db) {
          const int f = (s * 2 + db) * 2;
          const bf16x8 vf = cat8(vq[f], vq[f + 1]);
          accO[db] = MFMA(vf, pf, accO[db]);
        }
      }
    }
  }
  const float lt = l + shx(l, 32, lane);
  const float inv = 1.f / lt;
#pragma unroll
  for (int db = 0; db < 2; ++db)
#pragma unroll
    for (int g4 = 0; g4 < 4; ++g4) {
      const int d = 32 * db + 8 * g4 + 4 * h;
      float o0 = accO[db][4 * g4 + 0] * inv, o1 = accO[db][4 * g4 + 1] * inv, o2 = accO[db][4 * g4 + 2] * inv, o3 = accO[db][4 * g4 + 3] * inv;
      if (mode == 0) {
        const u32x2 gv = *(const u32x2*)(z + qtok * ZS + goff + d);
        o0 *= silu(bflo(gv.x)); o1 *= silu(bfhi(gv.x)); o2 *= silu(bflo(gv.y)); o3 *= silu(bfhi(gv.y));
        u32x2 ov; ov.x = pk2(o0, o1); ov.y = pk2(o2, o3);
        *(u32x2*)(y + qtok * YW + ycol + d) = ov;
      } else {
        u32x2 ov; ov.x = pk2(o0, o1); ov.y = pk2(o2, o3);
        *(u32x2*)(z + qtok * ZS + qoff + d) = ov;
      }
    }
  if (mode == 1 && h == 0) lse[qtok * 24 + lidx] = m + flog2(lt);
}

DI void diff_item(const u16* __restrict__ z, const u16* __restrict__ vt, unsigned tok0, int T, int hc, int i0, int st, int kv0, int kv1, float slope2,
                  u16* __restrict__ opart, float* __restrict__ mlpart, char* smem) {
  constexpr unsigned ZS = OCOLS_PAD;
  const int tid = opaque_tid(), lane = tid & 63, wave = tid >> 6, r = lane & 31, h = lane >> 5;
  const int qi = i0 + 32 * wave + r;
  const u16* __restrict__ zh = z + hc * 128;
  const unsigned qto = (tok0 + (unsigned)qi) * ZS;
  const float scale2 = 0.125f * LOG2E;
  unsigned c0pk = 0u, c1pk = 0u, bpk = 0u;
  if (h == 0) {
    const unsigned shi = pk2(slope2, 0.f) & 0xffffu;
    const unsigned slo = pk2(slope2 - __uint_as_float(shi << 16), 0.f) & 0xffffu;
    const unsigned c0 = pk2((float)r, 0.f) & 0xffffu, c1 = pk2((float)(32 + r), 0.f) & 0xffffu;
    c0pk = c0 | (c0 << 16); c1pk = c1 | (c1 << 16); bpk = shi | (slo << 16);
  }
  bf16x8 qf[4];
#pragma unroll
  for (int ks = 0; ks < 4; ++ks) {
    const u32x4 qv = *(const u32x4*)(zh + (qto + (unsigned)(st * 64 + 16 * ks + 8 * h)));
    u32x4 qs;
    qs.x = pk2(bflo(qv.x) * scale2, bfhi(qv.x) * scale2); qs.y = pk2(bflo(qv.y) * scale2, bfhi(qv.y) * scale2);
    qs.z = pk2(bflo(qv.z) * scale2, bfhi(qv.z) * scale2); qs.w = pk2(bflo(qv.w) * scale2, bfhi(qv.w) * scale2);
    qf[ks] = __builtin_bit_cast(bf16x8, qs);
  }
  f32x16 accO[4];
#pragma unroll
  for (int db = 0; db < 4; ++db) accO[db] = zero16();
  float m = 0.f, l = 0.f;
  constexpr int BUFB = 8192 + 16384;
  const int srow = lane >> 3, spos = lane & 7;
  const int ch_ = spos ^ ((4 * wave + (srow >> 1)) & 7);
  const unsigned sk = (tok0 + (unsigned)(8 * wave + srow)) * ZS + 1024u + (unsigned)(st * 64 + ch_ * 8);
  const unsigned sv = (tok0 * 8u + (unsigned)hc * (unsigned)T) * 128u + (unsigned)(8 * wave + srow) * (unsigned)T + (unsigned)(ch_ * 8);
#define DSTAGE(BUF_, KB_) { \
    _Pragma("unroll") for (int i = 0; i < 2; ++i) __builtin_amdgcn_global_load_lds((const unsigned*)(zh + (sk + (unsigned)((KB_) + 32 * i) * ZS)), (unsigned*)(smem + (BUF_) * BUFB + (wave + 4 * i) * 1024), 16, 0, 0); \
    _Pragma("unroll") for (int i = 0; i < 4; ++i) __builtin_amdgcn_global_load_lds((const unsigned*)(vt + (sv + (unsigned)(32 * i) * (unsigned)T + (unsigned)(KB_))), (unsigned*)(smem + (BUF_) * BUFB + 8192 + (wave + 4 * i) * 1024), 16, 0, 0); }
  __syncthreads();
  DSTAGE(0, kv0);
  __syncthreads();
  const int fk_ = (r >> 1) & 7;
  int buf = 0;
#pragma unroll 1
  for (int kb = kv0; kb < kv1; kb += 64, buf ^= 1) {
    if (kb + 64 < kv1) DSTAGE(buf ^ 1, kb + 64);
    const char* Kb = smem + buf * BUFB + r * 128;
    const char* Vb = smem + buf * BUFB + 8192 + r * 128;
    f32x16 accS[2] = {zero16(), zero16()};
    __builtin_amdgcn_s_setprio(1);
#pragma unroll
    for (int u = 0; u < 2; ++u)
#pragma unroll
      for (int ks = 0; ks < 4; ++ks) {
        const bf16x8 a = *(const bf16x8*)(Kb + u * 4096 + (((2 * ks + h) ^ fk_) << 4));
        accS[u] = MFMA(a, qf[ks], accS[u]);
      }
    const int q0w = i0 + 32 * wave;
    const bool left = (kb + 63 <= q0w), right = (kb >= q0w + 31);
    const float cl = left ? slope2 * (float)(qi - kb) : (right ? -slope2 * (float)(qi - kb) : 0.f);
    {
      const float nref = -(m + cl);
      const unsigned rhi = pk2(nref, 0.f) & 0xffffu;
      const unsigned rlo = pk2(nref - __uint_as_float(rhi << 16), 0.f) & 0xffffu;
      const unsigned rpk = (h == 0) ? (rhi | (rlo << 16)) : 0u, opk = (h == 0) ? 0x3f803f80u : 0u;
      const unsigned spk = left ? bpk : (right ? (bpk ^ 0x80008000u) : 0u);
      const u32x4 a0 = {c0pk, opk, 0u, 0u}, a1 = {c1pk, opk, 0u, 0u}, bb = {spk, rpk, 0u, 0u};
      accS[0] = MFMA(__builtin_bit_cast(bf16x8, a0), __builtin_bit_cast(bf16x8, bb), accS[0]);
      accS[1] = MFMA(__builtin_bit_cast(bf16x8, a1), __builtin_bit_cast(bf16x8, bb), accS[1]);
    }
    __builtin_amdgcn_s_setprio(0);
    if (!(left || right)) {
      const float d0 = (float)(qi - kb - 4 * h);
#pragma unroll
      for (int u = 0; u < 2; ++u)
#pragma unroll
        for (int e = 0; e < 16; ++e) {
          const float dd = fabsf(d0 - (float)(32 * u + 8 * (e >> 2) + (e & 3)));
          accS[u][e] -= slope2 * dd;
        }
    }
    float ps = 0.f;
#pragma unroll
    for (int u = 0; u < 2; ++u)
#pragma unroll
      for (int e = 0; e < 16; ++e) { const float p = fexp2(accS[u][e]); accS[u][e] = p; ps += p; }
    if (__builtin_amdgcn_ballot_w64(ps > 65536.f) != 0ull) {
      float pm = 0.f;
#pragma unroll
      for (int u = 0; u < 2; ++u)
#pragma unroll
        for (int e = 0; e < 16; ++e) pm = fmaxf(pm, accS[u][e]);
      pm = fmaxf(pm, shx(pm, 32, lane));
      const float delta = pm > 1.f ? floorf(flog2(pm)) : 0.f;
      const float sc = fexp2(-delta);
      ps *= sc; l *= sc; m += delta;
#pragma unroll
      for (int db = 0; db < 4; ++db)
#pragma unroll
        for (int e = 0; e < 16; ++e) accO[db][e] *= sc;
#pragma unroll
      for (int u = 0; u < 2; ++u)
#pragma unroll
        for (int e = 0; e < 16; ++e) accS[u][e] *= sc;
    }
    l += ps;
    __builtin_amdgcn_s_setprio(1);
#pragma unroll
    for (int u = 0; u < 2; ++u)
#pragma unroll
      for (int s2 = 0; s2 < 2; ++s2) {
        u32x4 pw;
        pw.x = pk2(accS[u][8 * s2 + 0], accS[u][8 * s2 + 1]); pw.y = pk2(accS[u][8 * s2 + 2], accS[u][8 * s2 + 3]);
        pw.z = pk2(accS[u][8 * s2 + 4], accS[u][8 * s2 + 5]); pw.w = pk2(accS[u][8 * s2 + 6], accS[u][8 * s2 + 7]);
        const bf16x8 pf = __builtin_bit_cast(bf16x8, pw);
#pragma unroll
        for (int db = 0; db < 4; ++db) {
          const bf16x8 vf = *(const bf16x8*)(Vb + db * 4096 + (((4 * u + 2 * s2 + h) ^ fk_) << 4));
          accO[db] = MFMA(vf, pf, accO[db]);
        }
      }
    __builtin_amdgcn_s_setprio(0);
    __syncthreads();
  }
#undef DSTAGE
  const float lt = l + shx(l, 32, lane);
  if (h == 0) { float2 mlv; mlv.x = m; mlv.y = lt; *(float2*)(mlpart + ((size_t)(tok0 + (unsigned)qi) * 8 + hc) * 2) = mlv; }
  __syncthreads();
  u16* Ot = (u16*)smem;
#pragma unroll
  for (int db = 0; db < 4; ++db)
#pragma unroll
    for (int g4 = 0; g4 < 4; ++g4) {
      u32x2 ov; ov.x = pk2(accO[db][4 * g4 + 0], accO[db][4 * g4 + 1]); ov.y = pk2(accO[db][4 * g4 + 2], accO[db][4 * g4 + 3]);
      *(u32x2*)(Ot + (32 * wave + r) * 136 + 32 * db + 8 * g4 + 4 * h) = ov;
    }
  __syncthreads();
  int tid2 = tid; asm volatile("" : "+v"(tid2));
#pragma unroll
  for (int i = 0; i < 8; ++i) {
    const int c = tid2 + 256 * i, row = c >> 4, ch = c & 15;
    *(u32x4*)(opart + ((size_t)(tok0 + (unsigned)(i0 + row)) * 1024 + (unsigned)(hc * 128 + ch * 8))) = *(const u32x4*)(Ot + row * 136 + ch * 8);
  }
}

DI void diff_combine(const u16* __restrict__ z, const u16* __restrict__ opart, const float* __restrict__ mlpart, int nparts, float lam, float outscale,
                     const float* __restrict__ subg, u16* __restrict__ y) {
  constexpr int ZS = OCOLS_PAD;
  const int tid = opaque_tid(); const int lane = tid & 63, gw = blockIdx.x * 4 + (tid >> 6), nw = gridDim.x * 4;
  const int hcl = lane >> 3;
  for (int tok = gw; tok < TOK; tok += nw) {
    float o[16];
#pragma unroll
    for (int i = 0; i < 16; ++i) o[i] = 0.f;
#pragma unroll
    for (int st = 0; st < 2; ++st) {
      float M = -1e30f;
      for (int pt = 0; pt < nparts; ++pt) M = fmaxf(M, mlpart[(((size_t)(pt * 2 + st) * TOK + tok) * 8 + hcl) * 2]);
      float L = 0.f; float acc[16];
#pragma unroll
      for (int i = 0; i < 16; ++i) acc[i] = 0.f;
      for (int pt = 0; pt < nparts; ++pt) {
        const size_t base = (size_t)(pt * 2 + st) * TOK + tok;
        const float2 mlv = *(const float2*)(mlpart + (base * 8 + hcl) * 2);
        const float w = fexp2(mlv.x - M);
        L += mlv.y * w;
        const u32x4 a = *(const u32x4*)(opart + base * 1024 + lane * 16), b = *(const u32x4*)(opart + base * 1024 + lane * 16 + 8);
        acc[0] += w * bflo(a.x); acc[1] += w * bfhi(a.x); acc[2] += w * bflo(a.y); acc[3] += w * bfhi(a.y);
        acc[4] += w * bflo(a.z); acc[5] += w * bfhi(a.z); acc[6] += w * bflo(a.w); acc[7] += w * bfhi(a.w);
        acc[8] += w * bflo(b.x); acc[9] += w * bfhi(b.x); acc[10] += w * bflo(b.y); acc[11] += w * bfhi(b.y);
        acc[12] += w * bflo(b.z); acc[13] += w * bfhi(b.z); acc[14] += w * bflo(b.w); acc[15] += w * bfhi(b.w);
      }
      const float sc = (st == 0 ? 1.f : -lam) / L;
#pragma unroll
      for (int i = 0; i < 16; ++i) o[i] += acc[i] * sc;
    }
    float ss = 0.f;
#pragma unroll
    for (int i = 0; i < 16; ++i) ss += o[i] * o[i];
    ss += shx(ss, 1, lane); ss += shx(ss, 2, lane); ss += shx(ss, 4, lane);
    const float rs = rsqrtf(ss * (1.f / 128.f) + 1e-6f) * outscale;
    const int d0 = (lane & 7) * 16;
    const u32x4 ga = *(const u32x4*)(z + (size_t)tok * ZS + 3072 + lane * 16), gb = *(const u32x4*)(z + (size_t)tok * ZS + 3072 + lane * 16 + 8);
    const f32x4 s0 = *(const f32x4*)(subg + d0), s1 = *(const f32x4*)(subg + d0 + 4), s2 = *(const f32x4*)(subg + d0 + 8), s3 = *(const f32x4*)(subg + d0 + 12);
    u32x4 oa, ob;
    oa.x = pk2(o[0] * rs * s0.x * silu(bflo(ga.x)), o[1] * rs * s0.y * silu(bfhi(ga.x)));
    oa.y = pk2(o[2] * rs * s0.z * silu(bflo(ga.y)), o[3] * rs * s0.w * silu(bfhi(ga.y)));
    oa.z = pk2(o[4] * rs * s1.x * silu(bflo(ga.z)), o[5] * rs * s1.y * silu(bfhi(ga.z)));
    oa.w = pk2(o[6] * rs * s1.z * silu(bflo(ga.w)), o[7] * rs * s1.w * silu(bfhi(ga.w)));
    ob.x = pk2(o[8] * rs * s2.x * silu(bflo(gb.x)), o[9] * rs * s2.y * silu(bfhi(gb.x)));
    ob.y = pk2(o[10] * rs * s2.z * silu(bflo(gb.y)), o[11] * rs * s2.w * silu(bfhi(gb.y)));
    ob.z = pk2(o[12] * rs * s3.x * silu(bflo(gb.z)), o[13] * rs * s3.y * silu(bfhi(gb.z)));
    ob.w = pk2(o[14] * rs * s3.z * silu(bflo(gb.w)), o[15] * rs * s3.w * silu(bfhi(gb.w)));
    *(u32x4*)(y + (size_t)tok * YW + lane * 16) = oa;
    *(u32x4*)(y + (size_t)tok * YW + lane * 16 + 8) = ob;
  }
}

DI void gla_d1(const u16* __restrict__ z, unsigned tok0, int cn, int hd, int dir, unsigned item, const float* __restrict__ Wg, const float* __restrict__ bg,
               float* __restrict__ oout, u16* __restrict__ qebuf, float* __restrict__ kvbuf, float* __restrict__ decbuf, char* smem) {
  constexpr unsigned ZS = OCOLS_PAD;
  float* rank = (float*)smem;
  float* tots = rank + 1024;
  float* decay = tots + 256;
  u16* QE = (u16*)(smem + 5632);
  u16* KE = QE + 64 * 136;
  u16* KSt = KE + 64 * 136;
  u16* Vt = KSt + 128 * 68;
  u16* P = KE;
  const int tid = opaque_tid(), lane = tid & 63, wave = tid >> 6, r = lane & 31, h = lane >> 5;
  const int kd = tid & 127, th = tid >> 7;
  float wg[16];
#pragma unroll
  for (int i = 0; i < 16; ++i) wg[i] = Wg[(dir * 16 + i) * 512 + hd * 128 + kd];
  const float bias = bg[dir * 512 + hd * 128 + kd];
  const float qscale = 0.08838834764831845f;
  const int cbase = (int)tok0 + cn * 64 + (dir ? 63 : 0);
  const int sgn = dir ? -1 : 1;
  __syncthreads();
  {
    const int p = tid >> 2, r4 = (tid & 3) * 4;
    const u32x2 rv = *(const u32x2*)(z + ((unsigned)(cbase + sgn * p) * ZS + 6144u + (unsigned)(dir * 16 + r4)));
    f32x4 f; f.x = bflo(rv.x); f.y = bfhi(rv.x); f.z = bflo(rv.y); f.w = bfhi(rv.y);
    *(f32x4*)(rank + p * 16 + r4) = f;
  }
  __syncthreads();
  float run = 0.f;
#pragma unroll 8
  for (int j = 0; j < 32; ++j) {
    const int p = 32 * th + j;
    const f32x4* rp = (const f32x4*)(rank + p * 16);
    float acc = bias;
#pragma unroll
    for (int q4 = 0; q4 < 4; ++q4) {
      const f32x4 rv = rp[q4];
      acc += rv.x * wg[4 * q4 + 0] + rv.y * wg[4 * q4 + 1] + rv.z * wg[4 * q4 + 2] + rv.w * wg[4 * q4 + 3];
    }
    const float ls = (fminf(acc, 0.f) - __logf(1.f + __expf(-fabsf(acc)))) * (1.f / 16.f);
    run += ls;
    const unsigned lu = __float_as_uint(ls);
    QE[p * 136 + kd] = (u16)(lu & 0xffffu); KE[p * 136 + kd] = (u16)(lu >> 16);
  }
  tots[th * 128 + kd] = run;
  __syncthreads();
  const float t0 = tots[kd], t1 = tots[128 + kd];
  const float blast = t0 + t1;
  const float dec = __expf(blast);
  if (th == 0) { decay[kd] = dec; decbuf[item * 128u + (unsigned)kd] = dec; }
  float b = th ? t0 : 0.f;
  const u16* __restrict__ zc = z + (hd * 128 + kd);
#pragma unroll 16
  for (int j = 0; j < 32; ++j) {
    const int p = 32 * th + j;
    const float laj = __uint_as_float((unsigned)QE[p * 136 + kd] | ((unsigned)KE[p * 136 + kd] << 16));
    b += laj;
    const float e = __expf(b), ie = __expf(-b);
    const unsigned zo = (unsigned)(cbase + sgn * p) * ZS;
    const float q = bf2f(zc[zo + 4096u]), k = bf2f(zc[zo + 4608u]);
    QE[p * 136 + kd] = f2bf(q * e * qscale);
    const float ke = k * ie;
    KE[p * 136 + kd] = f2bf(ke);
    KSt[kd * 68 + p] = f2bf(ke * dec);
    Vt[kd * 68 + p] = zc[zo + 5120u];
  }
  __syncthreads();
#pragma unroll
  for (int i = 0; i < 4; ++i) {
    const int c = tid + 256 * i, row = c >> 4, ch = c & 15;
    *(u32x4*)(qebuf + (item * 8192u + (unsigned)(row * 128 + ch * 8))) = *(const u32x4*)(QE + row * 136 + ch * 8);
  }
  {
    const int sb = wave & 1, tb = wave >> 1;
    f32x16 s1 = zero16();
#pragma unroll
    for (int ks = 0; ks < 8; ++ks) {
      const bf16x8 a = *(const bf16x8*)(KE + (32 * sb + r) * 136 + 16 * ks + 8 * h);
      const bf16x8 bq = *(const bf16x8*)(QE + (32 * tb + r) * 136 + 16 * ks + 8 * h);
      s1 = MFMA(a, bq, s1);
    }
    __syncthreads();
    const int tp = 32 * tb + r;
#pragma unroll
    for (int g4 = 0; g4 < 4; ++g4) {
      const int s0 = 32 * sb + 8 * g4 + 4 * h;
      float v[4];
#pragma unroll
      for (int e = 0; e < 4; ++e) { const int sp = s0 + e; const bool keep = dir ? (sp < tp) : (sp <= tp); v[e] = keep ? s1[4 * g4 + e] : 0.f; }
      u32x2 pv; pv.x = pk2(v[0], v[1]); pv.y = pk2(v[2], v[3]);
      *(u32x2*)(P + tp * 72 + s0) = pv;
    }
  }
  __syncthreads();
  bf16x8 vfn[4];
#pragma unroll
  for (int ks = 0; ks < 4; ++ks) {
    const u16* vr = Vt + (32 * wave + r) * 68 + 16 * ks + 8 * h;
    vfn[ks] = cat8(*(const bf16x4*)vr, *(const bf16x4*)(vr + 4));
  }
  f32x16 o0 = zero16(), o1 = zero16();
#pragma unroll
  for (int ks = 0; ks < 4; ++ks) {
    const bf16x8 a0 = *(const bf16x8*)(P + (r) * 72 + 16 * ks + 8 * h);
    const bf16x8 a1 = *(const bf16x8*)(P + (32 + r) * 72 + 16 * ks + 8 * h);
    o0 = MFMA(a0, vfn[ks], o0); o1 = MFMA(a1, vfn[ks], o1);
  }
  {
    float* od = oout + (hd * 128 + 32 * wave + r);
#pragma unroll
    for (int e = 0; e < 16; ++e) {
      const int tp = 8 * (e >> 2) + 4 * h + (e & 3);
      od[(unsigned)(cbase + sgn * tp) * 512u] = o0[e];
      od[(unsigned)(cbase + sgn * (32 + tp)) * 512u] = o1[e];
    }
  }
#pragma unroll
  for (int kb = 0; kb < 4; ++kb) {
    f32x16 kv = zero16();
#pragma unroll
    for (int ks = 0; ks < 4; ++ks) {
      const u16* kr = KSt + (32 * kb + r) * 68 + 16 * ks + 8 * h;
      const bf16x8 a = cat8(*(const bf16x4*)kr, *(const bf16x4*)(kr + 4));
      kv = MFMA(a, vfn[ks], kv);
    }
#pragma unroll
    for (int g4 = 0; g4 < 4; ++g4) {
      f32x4 v4; v4.x = kv[4 * g4 + 0]; v4.y = kv[4 * g4 + 1]; v4.z = kv[4 * g4 + 2]; v4.w = kv[4 * g4 + 3];
      *(f32x4*)(kvbuf + (item * 16384u + (unsigned)((((wave * 4 + kb) * 4 + g4) * 64 + lane) * 4))) = v4;
    }
  }
}

DI void gla_d2(int nchunk, unsigned tok0, int hd, int dir, unsigned item0, const u16* __restrict__ qebuf, const float* __restrict__ kvbuf,
               const float* __restrict__ decbuf, float* __restrict__ oint, char* smem) {
  u16* QE = (u16*)smem;
  float* decay = (float*)(smem + 17408);
  const int tid = opaque_tid(), lane = tid & 63, wave = tid >> 6, r = lane & 31, h = lane >> 5;
  f32x16 S[4] = {zero16(), zero16(), zero16(), zero16()};
  const int sgn = dir ? -1 : 1;
  u32x4 qst[4]; float dst = 0.f;
  {
    const unsigned it0 = item0 + (unsigned)(dir ? nchunk - 1 : 0);
#pragma unroll
    for (int i = 0; i < 4; ++i) qst[i] = *(const u32x4*)(qebuf + (it0 * 8192u + (unsigned)((tid + 256 * i) * 8)));
    if (tid < 128) dst = decbuf[it0 * 128u + (unsigned)tid];
  }
#pragma unroll 1
  for (int c = 0; c < nchunk; ++c) {
    const int cn = dir ? nchunk - 1 - c : c;
    const unsigned item = item0 + (unsigned)cn;
    const int cbase = (int)tok0 + cn * 64 + (dir ? 63 : 0);
    __syncthreads();
#pragma unroll
    for (int i = 0; i < 4; ++i) { const int cc = tid + 256 * i; *(u32x4*)(QE + (cc >> 4) * 136 + (cc & 15) * 8) = qst[i]; }
    if (tid < 128) decay[tid] = dst;
    __syncthreads();
    if (c + 1 < nchunk) {
      const unsigned itn = item0 + (unsigned)(dir ? cn - 1 : cn + 1);
#pragma unroll
      for (int i = 0; i < 4; ++i) qst[i] = *(const u32x4*)(qebuf + (itn * 8192u + (unsigned)((tid + 256 * i) * 8)));
      if (tid < 128) dst = decbuf[itn * 128u + (unsigned)tid];
    }
    f32x4 kvr[16];
#pragma unroll
    for (int i = 0; i < 16; ++i) kvr[i] = *(const f32x4*)(kvbuf + (item * 16384u + (unsigned)(((wave * 16 + i) * 64 + lane) * 4)));
    f32x16 o0 = zero16(), o1 = zero16();
#pragma unroll
    for (int kb = 0; kb < 4; ++kb)
#pragma unroll
      for (int s2 = 0; s2 < 2; ++s2) {
        u32x4 pw;
        pw.x = pk2(S[kb][8 * s2 + 0], S[kb][8 * s2 + 1]); pw.y = pk2(S[kb][8 * s2 + 2], S[kb][8 * s2 + 3]);
        pw.z = pk2(S[kb][8 * s2 + 4], S[kb][8 * s2 + 5]); pw.w = pk2(S[kb][8 * s2 + 6], S[kb][8 * s2 + 7]);
        const bf16x8 sf = __builtin_bit_cast(bf16x8, pw);
        const u16* qr0 = QE + (r) * 136 + 32 * kb + 16 * s2 + 4 * h;
        const u16* qr1 = QE + (32 + r) * 136 + 32 * kb + 16 * s2 + 4 * h;
        const bf16x8 a0 = cat8(*(const bf16x4*)qr0, *(const bf16x4*)(qr0 + 8));
        const bf16x8 a1 = cat8(*(const bf16x4*)qr1, *(const bf16x4*)(qr1 + 8));
        o0 = MFMA(a0, sf, o0); o1 = MFMA(a1, sf, o1);
      }
    {
      float* od = oint + (hd * 128 + 32 * wave + r);
#pragma unroll
      for (int e = 0; e < 16; ++e) {
        const int tp = 8 * (e >> 2) + 4 * h + (e & 3);
        od[(unsigned)(cbase + sgn * tp) * 512u] = o0[e];
        od[(unsigned)(cbase + sgn * (32 + tp)) * 512u] = o1[e];
      }
    }
#pragma unroll
    for (int kb = 0; kb < 4; ++kb)
#pragma unroll
      for (int g4 = 0; g4 < 4; ++g4) {
        const f32x4 dv = *(const f32x4*)(decay + 32 * kb + 8 * g4 + 4 * h);
        const f32x4 kq = kvr[kb * 4 + g4];
        S[kb][4 * g4 + 0] = S[kb][4 * g4 + 0] * dv.x + kq.x; S[kb][4 * g4 + 1] = S[kb][4 * g4 + 1] * dv.y + kq.y;
        S[kb][4 * g4 + 2] = S[kb][4 * g4 + 2] * dv.z + kq.z; S[kb][4 * g4 + 3] = S[kb][4 * g4 + 3] * dv.w + kq.w;
      }
  }
}

DI void even_merge(const u16* __restrict__ z, const float* __restrict__ lse, u16* __restrict__ y) {
  constexpr int ZS = ECOLS;
  const int nthr = gridDim.x * NTHR;
  for (int it = blockIdx.x * NTHR + opaque_tid(); it < TOK * 64; it += nthr) {
    const int tok = it >> 6, ch = it & 63, hh = ch >> 3, d0 = (ch & 7) * 8;
    const float l0 = lse[tok * 24 + hh], l1 = lse[tok * 24 + 8 + hh], l2 = lse[tok * 24 + 16 + hh];
    const float mx = fmaxf(l0, fmaxf(l1, l2));
    float w0 = fexp2(l0 - mx), w1 = fexp2(l1 - mx), w2 = fexp2(l2 - mx);
    const float inv = 1.f / (w0 + w1 + w2); w0 *= inv; w1 *= inv; w2 *= inv;
    const u16* zr = z + (size_t)tok * ZS;
    const u32x4 a = *(const u32x4*)(zr + 2560 + hh * 64 + d0);
    const u32x4 b = *(const u32x4*)(zr + 2560 + 512 + hh * 64 + d0);
    const u32x4 c = *(const u32x4*)(zr + 2560 + 1024 + hh * 64 + d0);
    const u32x4 g = *(const u32x4*)(zr + 7168 + hh * 64 + d0);
    u32x4 o;
    o.x = pk2((w0 * bflo(a.x) + w1 * bflo(b.x) + w2 * bflo(c.x)) * silu(bflo(g.x)), (w0 * bfhi(a.x) + w1 * bfhi(b.x) + w2 * bfhi(c.x)) * silu(bfhi(g.x)));
    o.y = pk2((w0 * bflo(a.y) + w1 * bflo(b.y) + w2 * bflo(c.y)) * silu(bflo(g.y)), (w0 * bfhi(a.y) + w1 * bfhi(b.y) + w2 * bfhi(c.y)) * silu(bfhi(g.y)));
    o.z = pk2((w0 * bflo(a.z) + w1 * bflo(b.z) + w2 * bflo(c.z)) * silu(bflo(g.z)), (w0 * bfhi(a.z) + w1 * bfhi(b.z) + w2 * bfhi(c.z)) * silu(bfhi(g.z)));
    o.w = pk2((w0 * bflo(a.w) + w1 * bflo(b.w) + w2 * bflo(c.w)) * silu(bflo(g.w)), (w0 * bfhi(a.w) + w1 * bfhi(b.w) + w2 * bfhi(c.w)) * silu(bfhi(g.w)));
    *(u32x4*)(y + (size_t)tok * YW + 1024 + hh * 64 + d0) = o;
  }
}
DI void odd_merge(const u16* __restrict__ z, const float* __restrict__ of, const float* __restrict__ ob, const float* __restrict__ oif, const float* __restrict__ oib, const float* __restrict__ glag, u16* __restrict__ y) {
  constexpr int ZS = OCOLS_PAD;
  const int tid = opaque_tid(); const int lane = tid & 63, gw = blockIdx.x * 4 + (tid >> 6), nw = gridDim.x * 4;
  for (int tok = gw; tok < TOK; tok += nw) {
    const f32x4* pf = (const f32x4*)(of + (size_t)tok * 512 + lane * 8);
    const f32x4* pb = (const f32x4*)(ob + (size_t)tok * 512 + lane * 8);
    float v[8];
    { const f32x4* qf = (const f32x4*)(oif + (size_t)tok * 512 + lane * 8);
      const f32x4* qb = (const f32x4*)(oib + (size_t)tok * 512 + lane * 8);
      const f32x4 a = pf[0] + pb[0] + qf[0] + qb[0], b = pf[1] + pb[1] + qf[1] + qb[1];
      v[0] = a.x; v[1] = a.y; v[2] = a.z; v[3] = a.w; v[4] = b.x; v[5] = b.y; v[6] = b.z; v[7] = b.w; }
    float ss = 0.f;
#pragma unroll
    for (int i = 0; i < 8; ++i) ss += v[i] * v[i];
    ss += shx(ss, 1, lane); ss += shx(ss, 2, lane); ss += shx(ss, 4, lane); ss += shx(ss, 8, lane);
    const float rs = rsqrtf(ss * (1.f / 128.f) + 1e-6f);
    const int vd0 = (lane & 15) * 8;
    const f32x4 g0 = *(const f32x4*)(glag + vd0), g1 = *(const f32x4*)(glag + vd0 + 4);
    const u32x4 gt = *(const u32x4*)(z + (size_t)tok * ZS + 5632 + lane * 8);
    u32x4 o;
    o.x = pk2(v[0] * rs * g0.x * silu(bflo(gt.x)), v[1] * rs * g0.y * silu(bfhi(gt.x)));
    o.y = pk2(v[2] * rs * g0.z * silu(bflo(gt.y)), v[3] * rs * g0.w * silu(bfhi(gt.y)));
    o.z = pk2(v[4] * rs * g1.x * silu(bflo(gt.z)), v[5] * rs * g1.y * silu(bfhi(gt.z)));
    o.w = pk2(v[6] * rs * g1.z * silu(bflo(gt.w)), v[7] * rs * g1.w * silu(bfhi(gt.w)));
    *(u32x4*)(y + (size_t)tok * YW + 1024 + lane * 8) = o;
  }
}


#define XB_TMO      128
#define XB_XCNT(j)  (256  + 64 * (j))
#define XB_XSUB(j)  (1280 + 64 * (j))
#define XB_XGEN(j)  (2304 + 64 * (j))
#define XB_TOP      3328
#define XB_TOPGEN   3392
#define XCD_BAR_WORDS 3456
#define XB_SPIN_CAP (1u << 22)
#define LAS __attribute__((address_space(3)))
DI unsigned xb_ld(unsigned* p)              { return __hip_atomic_load(p, __ATOMIC_RELAXED, __HIP_MEMORY_SCOPE_AGENT); }
DI unsigned xb_add(unsigned* p, unsigned v) { return __hip_atomic_fetch_add(p, v, __ATOMIC_RELAXED, __HIP_MEMORY_SCOPE_AGENT); }
DI unsigned xb_xcc_id() { return (unsigned)__builtin_amdgcn_s_getreg((3 << 11) | 20) & 0xFu; }
#define XB_SPIN(cond, bar) do { unsigned _sp = 0; while (cond) { __builtin_amdgcn_s_sleep(1); \
    if ((++_sp & 255u) == 0u) { if (xb_ld(&(bar)[XB_TMO])) break; if (_sp > XB_SPIN_CAP) { atomicAdd(&(bar)[XB_TMO], 1u); break; } } } } while (0)
struct XcdBarrier { unsigned* bar; unsigned x; volatile LAS unsigned* st; };
DI XcdBarrier xcd_barrier_post(unsigned* bar, volatile LAS unsigned* st) {
  XcdBarrier b; b.bar = bar; b.x = xb_xcc_id(); b.st = st;
  if (threadIdx.x == 0) (void)xb_add(&bar[XB_XCNT(b.x)], 1u);
  return b;
}
DI void xcd_barrier_complete(unsigned* bar, unsigned x, unsigned& nloc, unsigned& nx) {
  const unsigned G = gridDim.x * gridDim.y * gridDim.z;
  unsigned sum, cnt, mine, sp = 0u;
  for (;;) {
    sum = 0u; cnt = 0u; mine = 0u;
#pragma unroll
    for (unsigned j = 0; j < 16; ++j) { const unsigned c = xb_ld(&bar[XB_XCNT(j)]); sum += c; cnt += (c > 0u) ? 1u : 0u; mine = (j == x) ? c : mine; }
    if (sum == G) break;
    __builtin_amdgcn_s_sleep(1);
    if ((++sp & 255u) == 0u) { if (xb_ld(&bar[XB_TMO])) break; if (sp > XB_SPIN_CAP) { atomicAdd(&bar[XB_TMO], 1u); break; } }
  }
  nloc = mine > 0u ? mine : 1u; nx = cnt > 0u ? cnt : 1u;
}
DI void xcd_barrier(const XcdBarrier& b) {
  asm volatile("s_waitcnt vmcnt(0)" ::: "memory");
  __syncthreads();
  if (threadIdx.x == 0) {
    unsigned* bar = b.bar;
    __builtin_amdgcn_s_waitcnt(0);
    unsigned nloc = b.st[0], nx = b.st[1];
    if (nloc == 0u) { xcd_barrier_complete(bar, b.x, nloc, nx); b.st[0] = nloc; b.st[1] = nx; }
    const unsigned old = xb_add(&bar[XB_XSUB(b.x)], 1u);
    const unsigned gen = old / nloc;
    if (old + 1u == (gen + 1u) * nloc) {
      __builtin_amdgcn_fence(__ATOMIC_RELEASE, "agent");
      asm volatile("s_waitcnt vmcnt(0)" ::: "memory");
      const unsigned og = xb_add(&bar[XB_TOP], 1u);
      const unsigned tg = og / nx;
      if (og + 1u == (tg + 1u) * nx) xb_add(&bar[XB_TOPGEN], 1u);
      else XB_SPIN(xb_ld(&bar[XB_TOPGEN]) == tg, bar);
      __builtin_amdgcn_fence(__ATOMIC_ACQUIRE, "agent");
      xb_add(&bar[XB_XGEN(b.x)], 1u);
      asm volatile("s_waitcnt vmcnt(0)" ::: "memory");
    } else {
      XB_SPIN(xb_ld(&bar[XB_XGEN(b.x)]) == gen, bar);
      __builtin_amdgcn_fence(__ATOMIC_ACQUIRE, "agent");
      asm volatile("s_waitcnt vmcnt(0)" ::: "memory");
    }
  }
  __syncthreads();
}

__global__ void __launch_bounds__(NTHR, 2) mega(Params p) {
  extern __shared__ __attribute__((aligned(16))) char smem[];
  cg::grid_group grid = cg::this_grid();
  __shared__ uint4 xb_words;
  if (threadIdx.x == 0) xb_words = make_uint4(0u, 0u, 0u, 0u);
  __syncthreads();
  const XcdBarrier xb = xcd_barrier_post(p.bar, (volatile LAS unsigned*)&xb_words);

  if (blockIdx.x == 0 && threadIdx.x < 64) p.ctr[threadIdx.x] = 0;
#pragma unroll
  for (int i = 0; i < 4; ++i) {
    const int j = i >> 1;
    if ((i & 1) == 0) prep_transpose(p.even_w_in + (size_t)j * DM * ECOLS, p.norm_g + i * DM, DM, ECOLS, ECOLS, p.wte_in + (size_t)j * ECOLS * DM, smem);
    else              prep_transpose(p.odd_w_in + (size_t)j * DM * OCOLS, p.norm_g + i * DM, DM, OCOLS, OCOLS_PAD, p.wto_in + (size_t)j * OCOLS_PAD * DM, smem);
    prep_transpose(((i & 1) ? p.odd_w_out : p.even_w_out) + (size_t)j * YW * DM, nullptr, YW, DM, DM, ((i & 1) ? p.wto_out : p.wte_out) + (size_t)j * DM * YW, smem);
  }
  grid.sync();

  for (int g = 0; g < NGROUP; ++g) {
    const int T = (g < 4) ? 2048 : 8192;
    const int nqb = T / 128;
    const float* xin = (g < 4) ? (p.x_prompt + (size_t)g * TOK * DM) : p.x_sample;
    float* xres = p.out + (size_t)g * TOK * DM;
#pragma unroll
    for (int layer = 0; layer < 4; ++layer) {
      const int j = layer >> 1;
      const float* xsrc = layer == 0 ? xin : xres;
      norm_rows(xsrc, p.hb);
      xcd_barrier(xb);
      int* ctr = p.ctr + g * 4 + layer;
      if ((layer & 1) == 0) {
        gemm_phase<0>(p.hb, DM, p.wte_in + (size_t)j * ECOLS * DM, DM, ECOLS / 128, p.z, ECOLS, nullptr, nullptr, nullptr, T, smem);
        xcd_barrier(xb);
        const int nA = 2048, nB = 3072;
        for (;;) {
          const int it = next_item(ctr, smem);
          if (it >= nA + nB) break;
          if (it < nA) {
            const int qb = it % nqb, hq = (it / nqb) & 15, b = it / (nqb * 16);
            const float slope = exp2f(-0.5f * (float)(hq + 1));
            const float sk = p.sink[j * 16 + hq] * LOG2E;
            band_item(p.z, (size_t)b * T, 1, 0, T, qb * 128, 128, hq * 64, 1024 + (hq >> 2) * 64, 1280 + (hq >> 2) * 64,
                      slope * LOG2E, sk, 1.f, 0, 1536 + hq * 64, p.y, hq * 64, nullptr, 0, smem);
          } else {
            const int i2 = it - nA, pr = i2 >> 10, rem = i2 & 1023;
            const int jj = rem % nqb, hh = (rem / nqb) & 7, b = rem / (nqb * 8);
            const int dil = pr == 0 ? 1 : (pr == 1 ? 4 : 16);
            const int res = jj % dil, gqb = jj / dil;
            const float slope = exp2f(-(float)(hh + 1));
            band_item(p.z, (size_t)b * T, dil, res, T / dil, gqb * 128, 64, 2560 + pr * 512 + hh * 64, 4096 + pr * 512 + hh * 64,
                      5632 + pr * 512 + hh * 64, slope * (float)dil * LOG2E, -1e30f, 0.f, 1, 0, nullptr, 0, p.lse, pr * 8 + hh, smem);
          }
        }
        xcd_barrier(xb);
        even_merge(p.z, p.lse, p.y);
        xcd_barrier(xb);
      } else {
        gemm_phase<0>(p.hb, DM, p.wto_in + (size_t)j * OCOLS_PAD * DM, DM, OCOLS_PAD / 128, p.z, OCOLS_PAD, nullptr, nullptr, p.vtb, T, smem);
        xcd_barrier(xb);
        const int nseq = TOK / T;
        const int nparts = (T > 2048) ? 2 : 1;
        const int nD = nseq * 8, nC = 2048 * nparts;
        const int nchunk = T / 64;
        for (;;) {
          const int it = next_item(ctr, smem);
          if (it >= 2048) break;
          const int cn = it % nchunk, cid = it / nchunk;
          const int dir = cid & 1, hd = (cid >> 1) & 3, b = cid >> 3;
          gla_d1(p.z, (unsigned)(b * T), cn, hd, dir, (unsigned)it, p.gate2 + (size_t)j * 2 * 16 * 512, p.bgate + j * 2 * 512,
                 dir ? p.ob : p.of, p.qebuf, p.kvbuf, p.decbuf, smem);
        }
        xcd_barrier(xb);
        const float lam_init = uni(0.8f - 0.6f * expf(-0.3f * (float)layer));
        float lam;
        {
          const float* lp = p.diff_lambda + j * 256;
          float s01 = 0.f, s23 = 0.f;
          for (int i = 0; i < 64; ++i) { s01 += lp[i] * lp[64 + i]; s23 += lp[128 + i] * lp[192 + i]; }
          lam = uni(expf(s01) - expf(s23) + lam_init);
        }
        for (;;) {
          const int it = next_item(ctr + 32, smem);
          if (it >= nD + nC) break;
          if (it < nD) {
            const int dir = it & 1, hd = (it >> 1) & 3, b = it >> 3;
            gla_d2(nchunk, (unsigned)(b * T), hd, dir, (unsigned)(it * nchunk), p.qebuf, p.kvbuf, p.decbuf, dir ? p.oib : p.oif, smem);
          } else {
            const int i2 = it - nD;
            const int pt = i2 % nparts, st = (i2 / nparts) & 1, i3 = i2 / (2 * nparts);
            const int qb = i3 % nqb, hc = (i3 / nqb) & 7, b = i3 / (nqb * 8);
            const float slope = exp2f(-(float)(hc + 1));
            const int klen = T / nparts;
            diff_item(p.z, p.vtb, (unsigned)(b * T), T, hc, qb * 128, st, pt * klen, (pt + 1) * klen, uni(slope * LOG2E),
                      p.opart + (size_t)(pt * 2 + st) * TOK * 1024, p.mlpart + (size_t)(pt * 2 + st) * TOK * 16, smem);
          }
        }
        xcd_barrier(xb);
        odd_merge(p.z, p.of, p.ob, p.oif, p.oib, p.gla_g + j * 128, p.y);
        diff_combine(p.z, p.opart, p.mlpart, nparts, lam, 1.f - lam_init, p.subln_g + j * 128, p.y);
        xcd_barrier(xb);
      }
      gemm_phase<1>(p.y, YW, ((layer & 1) ? p.wto_out : p.wte_out) + (size_t)j * DM * YW, YW, DM / 128, nullptr, 0, xsrc, xres, nullptr, T, smem);
      xcd_barrier(xb);
    }
    final_norm_rows(xres, p.final_g);
  }
}

extern "C" void kernel_launch(void* const* d_in, const int* in_sizes, int n_in, void* d_out, int out_size, void* d_ws, size_t ws_size,
                              hipStream_t stream) {
  static int grid_blocks = 0;
  if (!grid_blocks) {
    int dev = 0, cus = 0, per_cu = 0;
    hipGetDevice(&dev);
    hipDeviceGetAttribute(&cus, hipDeviceAttributeMultiprocessorCount, dev);
    hipFuncSetAttribute((const void*)mega, hipFuncAttributeMaxDynamicSharedMemorySize, SMEM_BYTES);
    hipOccupancyMaxActiveBlocksPerMultiprocessor(&per_cu, mega, NTHR, SMEM_BYTES);
    if (per_cu > 2) per_cu = 2;
    if (per_cu < 1) per_cu = 1;
    grid_blocks = cus * per_cu;
  }
  Params p{};
  p.x_prompt = (const float*)d_in[0]; p.x_sample = (const float*)d_in[1]; p.norm_g = (const float*)d_in[2]; p.final_g = (const float*)d_in[3];
  p.even_w_in = (const float*)d_in[4]; p.even_w_out = (const float*)d_in[5]; p.sink = (const float*)d_in[6];
  p.odd_w_in = (const float*)d_in[7]; p.odd_w_out = (const float*)d_in[8]; p.diff_lambda = (const float*)d_in[9];
  p.subln_g = (const float*)d_in[10]; p.gate2 = (const float*)d_in[11]; p.bgate = (const float*)d_in[12]; p.gla_g = (const float*)d_in[13];
  p.out = (float*)d_out;
  char* w = (char*)d_ws; size_t off = 0;
  auto take = [&](size_t bytes) { char* q = w + off; off += (bytes + 255) & ~(size_t)255; return q; };
  p.wte_in = (u16*)take((size_t)2 * ECOLS * DM * 2);
  p.wto_in = (u16*)take((size_t)2 * OCOLS_PAD * DM * 2);
  p.wte_out = (u16*)take((size_t)2 * DM * YW * 2);
  p.wto_out = (u16*)take((size_t)2 * DM * YW * 2);
  p.hb = (u16*)take((size_t)TOK * DM * 2);
  p.z = (u16*)take((size_t)TOK * ECOLS * 2);
  p.y = (u16*)take((size_t)TOK * YW * 2);
  p.lse = (float*)take((size_t)TOK * 24 * 4);
  p.of = (float*)take((size_t)TOK * 512 * 4);
  p.ob = (float*)take((size_t)TOK * 512 * 4);
  p.oif = (float*)take((size_t)TOK * 512 * 4);
  p.oib = (float*)take((size_t)TOK * 512 * 4);
  p.vtb = (u16*)take((size_t)TOK * 1024 * 2);
  p.opart = (u16*)take((size_t)4 * TOK * 1024 * 2);
  p.mlpart = (float*)take((size_t)4 * TOK * 16 * 4);
  p.qebuf = (u16*)take((size_t)2048 * 8192 * 2);
  p.kvbuf = (float*)take((size_t)2048 * 16384 * 4);
  p.decbuf = (float*)take((size_t)2048 * 128 * 4);
  p.ctr = (int*)take(512);
  p.bar = (unsigned*)take(XCD_BAR_WORDS * 4);
  (void)hipMemsetAsync(p.bar, 0, XCD_BAR_WORDS * 4, stream);
  void* args[] = {&p};
  hipError_t e = hipLaunchCooperativeKernel((const void*)mega, dim3(grid_blocks), dim3(NTHR), args, SMEM_BYTES, stream);
  if (e != hipSuccess) fprintf(stderr, "cooperative launch failed: %s (grid %d)\n", hipGetErrorString(e), grid_blocks);
}
```
